# Optimizing an MI355X kernel written in HIP

```python
import jax, jax.numpy as jnp
from jax import lax
import numpy as np

D_MODEL = 2048
BATCH = 2
SEQ = 16384
DEPTH = 1
DEC_BATCH = 8
DEC_SEQ = 32
PAST_LEN = 4096

CHUNK = 64
D_PLE = 256
RMS_EPS = 1e-6
GLA_HEADS = 4
GLA_DK = D_MODEL // 16
GLA_DV = D_MODEL // 8
GLA_KW = GLA_HEADS * GLA_DK
GLA_WIDTH = GLA_HEADS * GLA_DV
GLA_RANK = 16
GLA_TAU = 16.0
SWA_HEADS = 16
SWA_KV_HEADS = 4
SWA_HEAD_DIM = 64
SWA_GROUP = SWA_HEADS // SWA_KV_HEADS
SWA_WIDTH = SWA_HEADS * SWA_HEAD_DIM
SWA_KVW = SWA_KV_HEADS * SWA_HEAD_DIM
WINDOW = 128
MIX_WIDTH = GLA_WIDTH + SWA_WIDTH
IN_SIZES = (GLA_KW, GLA_KW, GLA_WIDTH, GLA_WIDTH, GLA_RANK, SWA_WIDTH, SWA_KVW, SWA_KVW, SWA_WIDTH)
IN_DIM = GLA_KW * 2 + GLA_WIDTH * 2 + GLA_RANK + SWA_WIDTH * 2 + SWA_KVW * 2

kernel_name = "hymba_gla_swa_sink_stream_step"


def rmsnorm(x, g):
    xf = x.astype(jnp.float32)
    y = xf * lax.rsqrt(jnp.mean(xf * xf, axis=-1, keepdims=True) + RMS_EPS)
    return (y * g.astype(jnp.float32)).astype(x.dtype)


def split_columns(u):
    outs, off = [], 0
    for size in IN_SIZES:
        outs.append(u[..., off:off + size])
        off += size
    return outs


def gla_chunk(s, xs):
    q, k, v, g = xs
    c = q.shape[-2]
    b = jnp.cumsum(g, axis=-2)
    b_last = b[..., -1:, :]
    qe = q * jnp.exp(b)
    ke = k * jnp.exp(-b)
    causal = jnp.tril(jnp.ones((c, c), dtype=bool))
    a = jnp.where(causal, jnp.einsum('bhik,bhjk->bhij', qe, ke), 0.0)
    o = jnp.einsum('bhij,bhjv->bhiv', a, v) + jnp.einsum('bhik,bhkv->bhiv', qe, s)
    s_new = jnp.exp(b_last[..., 0, :])[..., None] * s + jnp.einsum('bhjk,bhjv->bhkv', k * jnp.exp(b_last - b), v)
    return s_new, o


def gla_forward(s0, q, k, v, g):
    bsz, hh, length, _ = q.shape
    c = min(CHUNK, length)
    nc = length // c
    def to_chunks(t):
        return jnp.moveaxis(t.reshape(bsz, hh, nc, c, t.shape[-1]), 2, 0)
    s, o = lax.scan(gla_chunk, s0, (to_chunks(q), to_chunks(k), to_chunks(v), to_chunks(g)))
    o = jnp.moveaxis(o, 0, 2).reshape(bsz, hh, length, v.shape[-1])
    return s, o


def sink_attention(q, k, v, sinks, mask):
    s = jnp.einsum('...qhgd,...khd->...hgqk', q, k).astype(jnp.float32) * (SWA_HEAD_DIM ** -0.5)
    if mask is not None:
        s = jnp.where(mask, s, jnp.finfo(jnp.float32).min)
    sink = sinks.astype(jnp.float32)[..., None, None]
    m = jnp.maximum(jnp.max(s, axis=-1, keepdims=True), sink)
    pr = jnp.exp(s - m)
    w = pr / (jnp.sum(pr, axis=-1, keepdims=True) + jnp.exp(sink - m))
    return jnp.einsum('...hgqk,...khd->...qhgd', w.astype(v.dtype), v)


def swa_prompt(q, k, v, sinks):
    bsz, length = q.shape[0], q.shape[1]
    nc = length // CHUNK
    nb = WINDOW // CHUNK
    pad = ((0, 0), (WINDOW, 0), (0, 0), (0, 0))
    kp = jnp.pad(k, pad).reshape(bsz, nc + nb, CHUNK, SWA_KV_HEADS, SWA_HEAD_DIM)
    vp = jnp.pad(v, pad).reshape(bsz, nc + nb, CHUNK, SWA_KV_HEADS, SWA_HEAD_DIM)
    kb = jnp.concatenate([kp[:, i:i + nc] for i in range(nb + 1)], axis=2)
    vb = jnp.concatenate([vp[:, i:i + nc] for i in range(nb + 1)], axis=2)
    qb = q.reshape(bsz, nc, CHUNK, SWA_KV_HEADS, SWA_GROUP, SWA_HEAD_DIM)
    key_pos = jnp.arange(nc)[:, None] * CHUNK - WINDOW + jnp.arange(WINDOW + CHUNK)[None, :]
    mask = (key_pos >= 0)[:, None, None, None, :]
    o = sink_attention(qb, kb, vb, sinks, mask)
    return o.reshape(bsz, length, SWA_WIDTH)


def swa_sample(q, k, v, k_past, v_past, sinks):
    bsz, length = q.shape[0], q.shape[1]
    kk = jnp.concatenate([k_past.astype(k.dtype), k], axis=1)
    vv = jnp.concatenate([v_past.astype(v.dtype), v], axis=1)
    o = sink_attention(q, kk, vv, sinks, None)
    return o.reshape(bsz, length, SWA_WIDTH)


def trunk_layer(h, p_l, gla_s0, k_past, v_past, g_mix, w_in, w_gate_up, b_gate, g_gla_out,
                swa_sinks, w_out, g_ple, w_ple_gate, w_ple_proj):
    bsz, length, _ = h.shape
    n = rmsnorm(h, g_mix)
    u = n @ w_in
    q1, k1, v1, z1, lr, q2, k2, v2, z2 = split_columns(u)
    def heads(t, d):
        return t.reshape(bsz, length, GLA_HEADS, d).transpose(0, 2, 1, 3).astype(jnp.float32)
    g = jax.nn.log_sigmoid((lr @ w_gate_up + b_gate).astype(jnp.float32)) / GLA_TAU
    gla_s, o1 = gla_forward(gla_s0.astype(jnp.float32), heads(q1, GLA_DK) * (GLA_DK ** -0.5),
                            heads(k1, GLA_DK), heads(v1, GLA_DV), heads(g, GLA_DK))
    o1 = rmsnorm(o1.transpose(0, 2, 1, 3), g_gla_out).astype(h.dtype)
    o1 = o1.reshape(bsz, length, GLA_WIDTH) * jax.nn.silu(z1)
    qh = q2.reshape(bsz, length, SWA_KV_HEADS, SWA_GROUP, SWA_HEAD_DIM)
    kh = k2.reshape(bsz, length, SWA_KV_HEADS, SWA_HEAD_DIM)
    vh = v2.reshape(bsz, length, SWA_KV_HEADS, SWA_HEAD_DIM)
    if k_past is None:
        o2 = swa_prompt(qh, kh, vh, swa_sinks)
        keep = min(WINDOW, length)
        k_keep, v_keep = kh[:, length - keep:], vh[:, length - keep:]
    else:
        o2 = swa_sample(qh, kh, vh, k_past, v_past, swa_sinks)
        k_keep, v_keep = kh, vh
    o2 = o2 * jax.nn.silu(z2)
    h = h + jnp.concatenate([o1, o2], axis=-1) @ w_out
    gate = jax.nn.sigmoid(rmsnorm(h, g_ple) @ w_ple_gate)
    h = h + gate * (p_l @ w_ple_proj)
    return h, gla_s, k_keep, v_keep


def setup_inputs(seed: int = 0) -> dict:
    key = jax.random.key(seed)
    ks = jax.random.split(key, 20)
    f32 = jnp.float32
    cache_len = min(WINDOW, PAST_LEN)
    nrm = lambda k, shape, scale: jax.random.normal(k, shape, f32) * scale
    return {
        "x_prompt": nrm(ks[0], (BATCH, SEQ, D_MODEL), 1.0),
        "x_sample": nrm(ks[1], (DEC_BATCH, DEC_SEQ, D_MODEL), 1.0),
        "p_prompt": nrm(ks[2], (DEPTH, BATCH, SEQ, D_PLE), 1.0),
        "p_sample": nrm(ks[3], (DEPTH, DEC_BATCH, DEC_SEQ, D_PLE), 1.0),
        "state_gla": nrm(ks[4], (DEPTH, DEC_BATCH, GLA_HEADS, GLA_DK, GLA_DV), 1.0),
        "cache_swa_k": nrm(ks[5], (DEPTH, DEC_BATCH, cache_len, SWA_KV_HEADS, SWA_HEAD_DIM), 1.0),
        "cache_swa_v": nrm(ks[6], (DEPTH, DEC_BATCH, cache_len, SWA_KV_HEADS, SWA_HEAD_DIM), 1.0),
        "g_mix": 1.0 + nrm(ks[7], (DEPTH, D_MODEL), 0.01),
        "w_in": nrm(ks[8], (DEPTH, D_MODEL, IN_DIM), D_MODEL ** -0.5),
        "w_gate_up": nrm(ks[9], (DEPTH, GLA_RANK, GLA_KW), GLA_RANK ** -0.5),
        "b_gate": nrm(ks[10], (DEPTH, GLA_KW), 0.01),
        "g_gla_out": 1.0 + nrm(ks[11], (DEPTH, GLA_DV), 0.01),
        "swa_sinks": nrm(ks[12], (DEPTH, SWA_KV_HEADS, SWA_GROUP), 0.5),
        "w_out": nrm(ks[13], (DEPTH, MIX_WIDTH, D_MODEL), MIX_WIDTH ** -0.5),
        "g_ple": 1.0 + nrm(ks[14], (DEPTH, D_MODEL), 0.01),
        "w_ple_gate": nrm(ks[15], (DEPTH, D_MODEL, D_MODEL), D_MODEL ** -0.5),
        "w_ple_proj": nrm(ks[16], (DEPTH, D_PLE, D_MODEL), D_PLE ** -0.5),
        "g_final": 1.0 + nrm(ks[17], (D_MODEL,), 0.01),
    }


def reference(x_prompt, x_sample, p_prompt, p_sample, state_gla, cache_swa_k, cache_swa_v,
              g_mix, w_in, w_gate_up, b_gate, g_gla_out, swa_sinks, w_out, g_ple, w_ple_gate,
              w_ple_proj, g_final):
    hp, hs = x_prompt, x_sample
    bp = x_prompt.shape[0]
    sp_list, kp_list, vp_list, ss_list, ks_list, vs_list = [], [], [], [], [], []
    for i in range(DEPTH):
        wts = (g_mix[i], w_in[i], w_gate_up[i], b_gate[i], g_gla_out[i], swa_sinks[i], w_out[i],
               g_ple[i], w_ple_gate[i], w_ple_proj[i])
        s0 = jnp.zeros((bp, GLA_HEADS, GLA_DK, GLA_DV), jnp.float32)
        hp, s_p, k_p, v_p = trunk_layer(hp, p_prompt[i], s0, None, None, *wts)
        hs, s_s, k_s, v_s = trunk_layer(hs, p_sample[i], state_gla[i], cache_swa_k[i], cache_swa_v[i], *wts)
        sp_list.append(s_p); kp_list.append(k_p); vp_list.append(v_p)
        ss_list.append(s_s); ks_list.append(k_s); vs_list.append(v_s)
    y_prompt = rmsnorm(hp, g_final)
    y_sample = rmsnorm(hs, g_final)
    return (y_prompt, y_sample, jnp.stack(sp_list), jnp.stack(kp_list), jnp.stack(vp_list),
            jnp.stack(ss_list), jnp.stack(ks_list), jnp.stack(vs_list))
```

```cpp
#include <hip/hip_runtime.h>
#include <hip/hip_cooperative_groups.h>
#include <cstdio>
namespace cg = cooperative_groups;

typedef unsigned short u16;
using bf16x8 = __attribute__((ext_vector_type(8))) short;
using f32x4 = __attribute__((ext_vector_type(4))) float;
using f32x16 = __attribute__((ext_vector_type(16))) float;
using u32x2 = __attribute__((ext_vector_type(2))) unsigned;
using u32x4 = __attribute__((ext_vector_type(4))) unsigned;

#define DI __device__ __forceinline__

constexpr int MP = 32768, MS = 256, MT = MP + MS;
constexpr int LSEQ = 16384, DM = 2048;
constexpr int NIN = 5888;
constexpr int NU = 2080;
constexpr float EPS = 1e-6f;

constexpr size_t O_Y = 0;
constexpr size_t O_SGP = (size_t)MT * 2048;
constexpr size_t O_KP = O_SGP + 262144;
constexpr size_t O_VP = O_KP + 65536;
constexpr size_t O_SGS = O_VP + 65536;
constexpr size_t O_KS = O_SGS + 1048576;
constexpr size_t O_VS = O_KS + 65536;

constexpr size_t al256(size_t x) { return (x + 255) & ~(size_t)255; }
constexpr size_t W_XB = 0;
constexpr size_t W_PB = W_XB + al256((size_t)MT * 2048 * 2);
constexpr size_t W_WIN = W_PB + al256((size_t)MT * 256 * 2);
constexpr size_t W_WOUT = W_WIN + al256((size_t)NIN * 2048 * 2);
constexpr size_t W_WG = W_WOUT + al256((size_t)2048 * 2048 * 2);
constexpr size_t W_WP = W_WG + al256((size_t)2048 * 2048 * 2);
constexpr size_t W_RSTDX = W_WP + al256((size_t)2048 * 256 * 2);
constexpr size_t W_Q1 = W_RSTDX + al256((size_t)MT * 4);
constexpr size_t W_K1 = W_Q1 + al256((size_t)MT * 512 * 2);
constexpr size_t W_VT1 = W_K1 + al256((size_t)MT * 512 * 2);
constexpr size_t W_Z1 = W_VT1 + al256((size_t)NU * 256 * 64 * 2);
constexpr size_t W_Q2 = W_Z1 + al256((size_t)MT * 1024 * 2);
constexpr size_t W_K2P = W_Q2 + al256((size_t)MT * 1024 * 2);
constexpr size_t W_K2S = W_K2P + al256((size_t)8 * 16384 * 64 * 2);
constexpr size_t W_VT2P = W_K2S + al256((size_t)32 * 160 * 64 * 2);
constexpr size_t W_VT2S = W_VT2P + al256((size_t)8 * 64 * 16384 * 2);
constexpr size_t W_Z2 = W_VT2S + al256((size_t)32 * 64 * 160 * 2);
constexpr size_t W_LR = W_Z2 + al256((size_t)MT * 1024 * 2);
constexpr size_t W_U = W_LR + al256((size_t)MT * 16 * 4);
constexpr size_t W_S = W_U + al256((size_t)NU * 32768 * 4);
constexpr size_t W_DEC = W_S + al256((size_t)NU * 32768 * 2);
constexpr size_t W_RSQH = W_DEC + al256((size_t)NU * 128 * 4);
constexpr size_t W_RSQH2 = W_RSQH + al256((size_t)MT * 4);
constexpr size_t W_END = W_RSQH2 + al256((size_t)MT * 4);
constexpr size_t W_MIX = W_XB;
constexpr size_t W_HB = W_Q1;
constexpr size_t W_STASH = W_Z1;
static_assert(W_HB + (size_t)MT * 2048 * 2 <= W_Z1, "HB alias overflow");
static_assert(W_END <= (size_t)1073741824, "workspace too large");

struct Params {
  const float *x_p, *x_s, *p_p, *p_s, *state, *ck, *cv, *g_mix, *w_in, *w_gu, *b_gate, *g_gla, *sinks, *w_out,
      *g_ple, *w_pg, *w_pp, *g_final;
  float* out;
  char* ws;
  int ph_lo, ph_hi;
};

extern __shared__ __attribute__((aligned(16))) unsigned char smem_raw[];

typedef const __attribute__((address_space(4))) Params* KParamsPtr;
__device__ __forceinline__ Params load_params() {
  KParamsPtr kp = (KParamsPtr)__builtin_amdgcn_kernarg_segment_ptr();
  asm volatile("" : "+s"(kp));
  Params r;
  r.x_p = kp->x_p; r.x_s = kp->x_s; r.p_p = kp->p_p; r.p_s = kp->p_s; r.state = kp->state; r.ck = kp->ck; r.cv = kp->cv;
  r.g_mix = kp->g_mix; r.w_in = kp->w_in; r.w_gu = kp->w_gu; r.b_gate = kp->b_gate; r.g_gla = kp->g_gla;
  r.sinks = kp->sinks; r.w_out = kp->w_out; r.g_ple = kp->g_ple; r.w_pg = kp->w_pg; r.w_pp = kp->w_pp;
  r.g_final = kp->g_final; r.out = kp->out; r.ws = kp->ws; r.ph_lo = kp->ph_lo; r.ph_hi = kp->ph_hi;
  return r;
}

DI unsigned pk_bf16(float a, float b) {
  unsigned r;
  asm("v_cvt_pk_bf16_f32 %0, %1, %2" : "=v"(r) : "v"(a), "v"(b));
  return r;
}
DI u16 f2bf(float a) { return (u16)(pk_bf16(a, 0.f) & 0xffffu); }
DI float bf2f(u16 v) { return __uint_as_float(((unsigned)v) << 16); }
DI float bflo(unsigned v) { return __uint_as_float(v << 16); }
DI float bfhi(unsigned v) { return __uint_as_float(v & 0xffff0000u); }
DI float sigmoidf_(float x) { return 1.f / (1.f + __expf(-x)); }
DI float siluf_(float x) { return x / (1.f + __expf(-x)); }
DI int get_tid() {
  int t = threadIdx.x;
  asm volatile("" : "+v"(t));
  return t;
}
DI float wave_sum(float v) {
#pragma unroll
  for (int o = 32; o >= 1; o >>= 1) v += __shfl_xor(v, o);
  return v;
}

constexpr int BM = 256, BK = 64, HALF = 128, HT = HALF * BK;
constexpr int SHM_B = 8 * HT * 2;

DI int lds_byte(int r, int c) {
  int st = (r >> 4) * 2 + (c >> 5), rr = r & 15, cc = c & 31, ob = rr * 64 + cc * 2;
  return st * 1024 + (ob ^ (((ob >> 9) & 1) << 5));
}
DI void stage_rc(int b, int& R, int& C) {
  int st = b / 1024, sb = b % 1024, swz = sb ^ (((sb >> 9) & 1) << 5);
  R = (st >> 1) * 16 + swz / 64;
  C = (st & 1) * 32 + (swz % 64) / 2;
}

DI void gemm_kloop(const u16* __restrict__ A, const u16* __restrict__ Bt, const int K, const int brow, const int bcol,
                   f32x4 (&acc)[2][2][4][2], const int tid_) {
  u16* shm = (u16*)smem_raw;
#define SA(b, h) (shm + ((b)*2 + (h)) * HT)
#define SB(b, h) (shm + (4 + (b)*2 + (h)) * HT)
#define STAGE(P, BASE, br, kt)                                                                       \
  do {                                                                                               \
    const char* _gb = (const char*)(BASE + ((size_t)(br)*K + (size_t)(kt)*BK));                      \
    asm volatile("" : "+s"(_gb));                                                                    \
    __builtin_amdgcn_global_load_lds((const unsigned*)(_gb + (size_t)so0),                           \
                                     (__attribute__((address_space(3))) unsigned*)((char*)(P) + lw), 16, 0, 0); \
    __builtin_amdgcn_global_load_lds((const unsigned*)(_gb + (size_t)so1),                           \
                                     (__attribute__((address_space(3))) unsigned*)((char*)(P) + lw + 8192), 16, 0, 0); \
  } while (0)
#define LDA(dst, b, h)                                                                               \
  for (int m = 0; m < 4; ++m)                                                                        \
    for (int k = 0; k < 2; ++k)                                                                      \
  dst[m][k] = *reinterpret_cast<const bf16x8*>((char*)SA(b, h) + lds_byte(wr * 64 + m * 16 + fr, k * 32 + fq * 8))
#define LDB(dst, b, h)                                                                               \
  for (int n = 0; n < 2; ++n)                                                                        \
    for (int k = 0; k < 2; ++k)                                                                      \
  dst[n][k] = *reinterpret_cast<const bf16x8*>((char*)SB(b, h) + lds_byte(wc * 32 + n * 16 + fr, k * 32 + fq * 8))
#define MMA(ai, bj, At_, Bt_)                                                                        \
  do {                                                                                               \
    __builtin_amdgcn_s_setprio(1);                                                                   \
    for (int m = 0; m < 4; ++m)                                                                      \
      for (int n = 0; n < 2; ++n)                                                                    \
        for (int k = 0; k < 2; ++k)                                                                  \
          acc[ai][bj][m][n] = __builtin_amdgcn_mfma_f32_16x16x32_bf16(Bt_[n][k], At_[m][k], acc[ai][bj][m][n], 0, 0, 0); \
    __builtin_amdgcn_s_setprio(0);                                                                   \
  } while (0)
#define WAIT_V(n) asm volatile("s_waitcnt vmcnt(" #n ")" ::: "memory")
#define WAIT_L(n) asm volatile("s_waitcnt lgkmcnt(" #n ")" ::: "memory")
#define BAR __builtin_amdgcn_s_barrier()
#define SCHED __builtin_amdgcn_sched_barrier(0)

  const int wid = __builtin_amdgcn_readfirstlane(tid_ >> 6), lane = tid_ & 63, wr = wid >> 2, wc = wid & 3, fr = lane & 15, fq = lane >> 4;
  const int sb0 = tid_ * 16;
  unsigned so0, so1;
  {
    int r_, c_;
    stage_rc(sb0, r_, c_);
    so0 = (unsigned)(r_ * K + c_) * 2u;
    stage_rc(sb0 + 8192, r_, c_);
    so1 = (unsigned)(r_ * K + c_) * 2u;
  }
  const int lw = wid * 1024;
#pragma unroll
  for (int a = 0; a < 2; ++a)
#pragma unroll
    for (int b = 0; b < 2; ++b)
#pragma unroll
      for (int m = 0; m < 4; ++m)
#pragma unroll
        for (int n = 0; n < 2; ++n) acc[a][b][m][n] = f32x4{0.f, 0.f, 0.f, 0.f};
  bf16x8 At[4][2], B0[2][2], B1[2][2];
  const int nt = K / BK;
  STAGE(SB(0, 0), Bt, bcol, 0);
  STAGE(SA(0, 0), A, brow, 0);
  STAGE(SB(0, 1), Bt, bcol + HALF, 0);
  STAGE(SA(0, 1), A, brow + HALF, 0);
  if (wr == 1) BAR;
  WAIT_V(4);
  BAR;
  STAGE(SB(1, 0), Bt, bcol, 1);
  STAGE(SA(1, 0), A, brow, 1);
  STAGE(SB(1, 1), Bt, bcol + HALF, 1);
  WAIT_V(6);
  BAR;
  for (int t = 0; t < nt - 2; t += 2) {
    LDB(B0, 0, 0); SCHED; LDA(At, 0, 0); STAGE(SA(1, 1), A, brow + HALF, t + 1);
    WAIT_L(8); BAR; WAIT_L(0); MMA(0, 0, At, B0); BAR; SCHED;
    LDB(B1, 0, 1); STAGE(SB(0, 0), Bt, bcol, t + 2);
    BAR; WAIT_L(0); MMA(0, 1, At, B1); BAR;
    LDA(At, 0, 1); STAGE(SA(0, 0), A, brow, t + 2);
    BAR; WAIT_L(0); MMA(1, 0, At, B0); BAR; SCHED;
    STAGE(SB(0, 1), Bt, bcol + HALF, t + 2);
    WAIT_V(6); BAR; MMA(1, 1, At, B1); BAR;
    LDB(B0, 1, 0); SCHED; LDA(At, 1, 0); STAGE(SA(0, 1), A, brow + HALF, t + 2);
    WAIT_L(8); BAR; WAIT_L(0); MMA(0, 0, At, B0); BAR; SCHED;
    LDB(B1, 1, 1); STAGE(SB(1, 0), Bt, bcol, t + 3);
    BAR; WAIT_L(0); MMA(0, 1, At, B1); BAR;
    LDA(At, 1, 1); STAGE(SA(1, 0), A, brow, t + 3);
    BAR; WAIT_L(0); MMA(1, 0, At, B0); BAR; SCHED;
    STAGE(SB(1, 1), Bt, bcol + HALF, t + 3);
    WAIT_V(6); BAR; MMA(1, 1, At, B1); BAR;
  }
  {
    LDB(B0, 0, 0); LDA(At, 0, 0); STAGE(SA(1, 1), A, brow + HALF, nt - 1);
    BAR; WAIT_L(0); MMA(0, 0, At, B0); BAR;
    LDB(B1, 0, 1); BAR; WAIT_L(0); MMA(0, 1, At, B1); BAR;
    LDA(At, 0, 1); WAIT_V(4); BAR; WAIT_L(0); MMA(1, 0, At, B0); MMA(1, 1, At, B1); BAR;
  }
  {
    LDB(B0, 1, 0); LDA(At, 1, 0); WAIT_V(2); BAR; WAIT_L(0); MMA(0, 0, At, B0); BAR;
    LDB(B1, 1, 1); WAIT_V(0); BAR; WAIT_L(0); MMA(0, 1, At, B1); BAR;
    LDA(At, 1, 1); BAR; WAIT_L(0); MMA(1, 0, At, B0); MMA(1, 1, At, B1); BAR;
  }
  if (wr == 0) BAR;
#undef SA
#undef SB
#undef STAGE
#undef LDA
#undef LDB
#undef MMA
}

DI bool next_tile(int it, int nM, int nN, int& pm, int& pn) {
  const int nb = gridDim.x, bid = blockIdx.x;
  int tl;
  if ((nb & 7) == 0) {
    int nloc = nb >> 3;
    tl = (it * 8 + (bid & 7)) * nloc + (bid >> 3);
  } else {
    tl = it * nb + bid;
  }
  if (tl >= nM * nN) return false;
  int nig = 8 * nN, g = tl / nig, rem = tl - g * nig, gsz = min(8, nM - g * 8);
  pm = g * 8 + rem % gsz;
  pn = rem / gsz;
  return true;
}

DI void transpose_tile(const float* __restrict__ src, int ldsrc, int K, int n0, int k0, u16* __restrict__ dst,
                       const float* __restrict__ gvec, int mode) {
  float* t = (float*)smem_raw;
  const int tid = get_tid();
  {
    int tn = tid & 63, tk = tid >> 6;
    int np = n0 + tn;
    int scol = np;
    float cs = 1.f;
    bool valid = true;
    if (mode == 1) {
      if (np < 3072) scol = np;
      else if (np < 5632) scol = np + 16;
      else if (np < 5648) scol = 3072 + (np - 5632);
      else valid = false;
      if (np < 512) cs = 0.08838834764831845f;
      else if (np >= 3072 && np < 4096) cs = 0.125f;
    }
#pragma unroll
    for (int i = 0; i < 8; ++i) {
      int k = tk * 8 + i;
      float v = 0.f;
      if (valid) {
        v = src[(size_t)(k0 + k) * ldsrc + scol] * cs;
        if (gvec) v *= gvec[k0 + k];
      }
      t[k * 65 + tn] = v;
    }
  }
  __syncthreads();
  {
    int tk2 = tid & 63, tn2 = tid >> 6;
#pragma unroll
    for (int i = 0; i < 8; ++i) {
      int n = tn2 * 8 + i;
      dst[(size_t)(n0 + n) * K + k0 + tk2] = f2bf(t[tk2 * 65 + n]);
    }
  }
  __syncthreads();
}

DI void phase_prep() {
  const Params P = load_params();
  const int tid = get_tid(), lane = tid & 63, wid = tid >> 6, nb = gridDim.x, bid = blockIdx.x;
  char* ws = P.ws;
  u16* XB = (u16*)(ws + W_XB);
  u16* PB = (u16*)(ws + W_PB);
  float* RSTDX = (float*)(ws + W_RSTDX);
  float* RSQH = (float*)(ws + W_RSQH);
  float* RSQH2 = (float*)(ws + W_RSQH2);
  for (int r = bid * 8 + wid; r < MT; r += nb * 8) {
    const float* xr = r < MP ? P.x_p + (size_t)r * 2048 : P.x_s + (size_t)(r - MP) * 2048;
    const float* pr = r < MP ? P.p_p + (size_t)r * 256 : P.p_s + (size_t)(r - MP) * 256;
    float ss = 0.f;
    u16* xb = XB + (size_t)r * 2048;
#pragma unroll
    for (int it = 0; it < 8; ++it) {
      f32x4 v = ((const f32x4*)xr)[it * 64 + lane];
      ss += v[0] * v[0] + v[1] * v[1] + v[2] * v[2] + v[3] * v[3];
      u32x2 o;
      o[0] = pk_bf16(v[0], v[1]);
      o[1] = pk_bf16(v[2], v[3]);
      ((u32x2*)xb)[it * 64 + lane] = o;
    }
    ss = wave_sum(ss);
    {
      f32x4 v = ((const f32x4*)pr)[lane];
      u32x2 o;
      o[0] = pk_bf16(v[0], v[1]);
      o[1] = pk_bf16(v[2], v[3]);
      ((u32x2*)(PB + (size_t)r * 256))[lane] = o;
    }
    if (lane == 0) {
      RSTDX[r] = rsqrtf(ss * (1.f / 2048.f) + EPS);
      RSQH[r] = 0.f;
      RSQH2[r] = 0.f;
    }
  }
  {
    const int T_IN = 92 * 32, T_OUT = 32 * 32, T_G = 32 * 32, T_P = 32 * 4;
    const int TT = T_IN + T_OUT + T_G + T_P;
    for (int tl = bid; tl < TT; tl += nb) {
      if (tl < T_IN) {
        int nt_ = tl / 32, kt_ = tl % 32;
        transpose_tile(P.w_in, 5648, 2048, nt_ * 64, kt_ * 64, (u16*)(ws + W_WIN), P.g_mix, 1);
      } else if (tl < T_IN + T_OUT) {
        int q = tl - T_IN, nt_ = q / 32, kt_ = q % 32;
        transpose_tile(P.w_out, 2048, 2048, nt_ * 64, kt_ * 64, (u16*)(ws + W_WOUT), nullptr, 0);
      } else if (tl < T_IN + T_OUT + T_G) {
        int q = tl - T_IN - T_OUT, nt_ = q / 32, kt_ = q % 32;
        transpose_tile(P.w_pg, 2048, 2048, nt_ * 64, kt_ * 64, (u16*)(ws + W_WG), P.g_ple, 0);
      } else {
        int q = tl - T_IN - T_OUT - T_G, nt_ = q / 4, kt_ = q % 4;
        transpose_tile(P.w_pp, 2048, 256, nt_ * 64, kt_ * 64, (u16*)(ws + W_WP), nullptr, 0);
      }
    }
  }
  const int gtid = bid * 512 + tid, gsz = nb * 512;
  {
    u16* K2S = (u16*)(ws + W_K2S);
    u16* VT2S = (u16*)(ws + W_VT2S);
    for (int i = gtid; i < 8 * 128 * 4 * 64; i += gsz) {
      int sb = i >> 15, pos = (i >> 8) & 127, kvh = (i >> 6) & 3, d = i & 63;
      K2S[((size_t)(sb * 4 + kvh) * 160 + pos) * 64 + d] = f2bf(P.ck[i]);
      VT2S[((size_t)(sb * 4 + kvh) * 64 + d) * 160 + pos] = f2bf(P.cv[i]);
    }
  }
  {
    u32x4* z = (u32x4*)((u16*)(ws + W_VT1) + (size_t)2048 * 16384);
    for (int i = gtid; i < 32 * 16384 / 8; i += gsz) z[i] = u32x4{0u, 0u, 0u, 0u};
  }
  {
    u16* S = (u16*)(ws + W_S) + (size_t)2048 * 32768;
    for (int i = gtid; i < 32 * 4096; i += gsz) {
      int su = i >> 12, q = i & 4095;
      int ln = q & 63, ks = (q >> 6) & 7, ntl = q >> 9;
      int dv = ntl * 32 + (ln & 31), dk0 = ks * 16 + (ln >> 5) * 8;
      const float* src = P.state + (size_t)su * 32768 + (size_t)dk0 * 256 + dv;
      u32x4 o;
      o[0] = pk_bf16(src[0], src[256]);
      o[1] = pk_bf16(src[512], src[768]);
      o[2] = pk_bf16(src[1024], src[1280]);
      o[3] = pk_bf16(src[1536], src[1792]);
      ((u32x4*)(S + (size_t)su * 32768))[q] = o;
    }
  }
}

DI void store_bf4(u16* p, f32x4 v) {
  u32x2 o;
  o[0] = pk_bf16(v[0], v[1]);
  o[1] = pk_bf16(v[2], v[3]);
  *(u32x2*)p = o;
}

DI void phase_inproj() {
  const Params P = load_params();
  char* ws = P.ws;
  const u16* XB = (const u16*)(ws + W_XB);
  const u16* WIN = (const u16*)(ws + W_WIN);
  const float* RSTDX = (const float*)(ws + W_RSTDX);
  const int tid = get_tid();
  const int wid = __builtin_amdgcn_readfirstlane(tid >> 6), wr = wid >> 2, wc = wid & 3;
  f32x4 acc[2][2][4][2];
  int pm, pn;
  for (int it = 0; next_tile(it, 129, 23, pm, pn); ++it) {
    const int brow = pm * 256, bcol = pn * 256;
    gemm_kloop(XB, WIN, 2048, brow, bcol, acc, tid);
    int te = tid;
    asm volatile("" : "+v"(te));
    const int fr = te & 15, fq = (te >> 4) & 3;
    int kind = 0, ld = 512, coff = 0;
    u16* dst = (u16*)(ws + W_Q1);
    if (pn < 2) { coff = pn * 256; }
    else if (pn < 4) { dst = (u16*)(ws + W_K1); coff = (pn - 2) * 256; }
    else if (pn < 8) { kind = 1; }
    else if (pn < 12) { dst = (u16*)(ws + W_Z1); ld = 1024; coff = (pn - 8) * 256; }
    else if (pn < 16) { dst = (u16*)(ws + W_Q2); ld = 1024; coff = (pn - 12) * 256; }
    else if (pn == 16) { kind = 2; }
    else if (pn == 17) { kind = 3; }
    else if (pn < 22) { dst = (u16*)(ws + W_Z2); ld = 1024; coff = (pn - 18) * 256; }
    else { kind = 4; }
    const int cb = wc * 32 + fq * 4;
    if (kind == 0) {
#pragma unroll
      for (int ai = 0; ai < 2; ++ai)
#pragma unroll
        for (int m = 0; m < 4; ++m) {
          const int row = brow + ai * 128 + wr * 64 + m * 16 + fr;
          const float rs = RSTDX[row];
          u16* dp = dst + (size_t)row * ld + coff + cb;
#pragma unroll
          for (int bj = 0; bj < 2; ++bj)
#pragma unroll
            for (int n = 0; n < 2; ++n) store_bf4(dp + bj * 128 + n * 16, acc[ai][bj][m][n] * rs);
          __builtin_amdgcn_sched_barrier(0);
        }
    } else if (kind == 1) {
      const int h = pn - 4;
#pragma unroll
      for (int ai = 0; ai < 2; ++ai)
#pragma unroll
        for (int m = 0; m < 4; ++m) {
          const int row = brow + ai * 128 + wr * 64 + m * 16 + fr;
          const float rs = RSTDX[row];
          int unit, t;
          if (row < MP) { unit = ((row >> 14) * 4 + h) * 256 + ((row & 16383) >> 6); t = row & 63; }
          else { unit = 2048 + ((row - MP) >> 5) * 4 + h; t = (row - MP) & 31; }
          u16* dp = (u16*)(ws + W_VT1) + ((size_t)unit * 256 + cb) * 64 + t;
#pragma unroll
          for (int bj = 0; bj < 2; ++bj)
#pragma unroll
            for (int n = 0; n < 2; ++n) {
              f32x4 v = acc[ai][bj][m][n] * rs;
              u16* d = dp + (bj * 128 + n * 16) * 64;
              d[0] = f2bf(v[0]); d[64] = f2bf(v[1]); d[128] = f2bf(v[2]); d[192] = f2bf(v[3]);
            }
          __builtin_amdgcn_sched_barrier(0);
        }
    } else if (kind == 2 || kind == 3) {
#pragma unroll
      for (int ai = 0; ai < 2; ++ai)
#pragma unroll
        for (int m = 0; m < 4; ++m) {
          const int row = brow + ai * 128 + wr * 64 + m * 16 + fr;
          const float rs = RSTDX[row];
          const bool isP = row < MP;
          const int b = row >> 14, pos = row & 16383;
          const int sT = row - MP, sb = sT >> 5, st = sT & 31;
#pragma unroll
          for (int bj = 0; bj < 2; ++bj)
#pragma unroll
            for (int n = 0; n < 2; ++n) {
              f32x4 v = acc[ai][bj][m][n] * rs;
              const int col = bj * 128 + n * 16 + cb;
              const int kvh = col >> 6, d0 = col & 63;
              if (kind == 2) {
                if (isP) {
                  store_bf4((u16*)(ws + W_K2P) + ((size_t)(b * 4 + kvh) * 16384 + pos) * 64 + d0, v);
                  if (pos >= LSEQ - 128)
                    *(f32x4*)(P.out + O_KP + ((size_t)(b * 128 + pos - (LSEQ - 128)) * 4 + kvh) * 64 + d0) = v;
                } else {
                  store_bf4((u16*)(ws + W_K2S) + ((size_t)(sb * 4 + kvh) * 160 + 128 + st) * 64 + d0, v);
                  *(f32x4*)(P.out + O_KS + (size_t)sT * 256 + col) = v;
                }
              } else {
                if (isP) {
                  u16* d = (u16*)(ws + W_VT2P) + ((size_t)(b * 4 + kvh) * 64 + d0) * 16384 + pos;
                  d[0] = f2bf(v[0]); d[16384] = f2bf(v[1]); d[32768] = f2bf(v[2]); d[49152] = f2bf(v[3]);
                  if (pos >= LSEQ - 128)
                    *(f32x4*)(P.out + O_VP + ((size_t)(b * 128 + pos - (LSEQ - 128)) * 4 + kvh) * 64 + d0) = v;
                } else {
                  u16* d = (u16*)(ws + W_VT2S) + ((size_t)(sb * 4 + kvh) * 64 + d0) * 160 + 128 + st;
                  d[0] = f2bf(v[0]); d[160] = f2bf(v[1]); d[320] = f2bf(v[2]); d[480] = f2bf(v[3]);
                  *(f32x4*)(P.out + O_VS + (size_t)sT * 256 + col) = v;
                }
              }
            }
          __builtin_amdgcn_sched_barrier(0);
        }
    } else {
      if (wc == 0 && fq < 4) {
#pragma unroll
        for (int ai = 0; ai < 2; ++ai)
#pragma unroll
          for (int m = 0; m < 4; ++m) {
            const int row = brow + ai * 128 + wr * 64 + m * 16 + fr;
            const float rs = RSTDX[row];
            *(f32x4*)((float*)(ws + W_LR) + (size_t)row * 16 + fq * 4) = acc[ai][0][m][0] * rs;
          }
      }
    }
  }
}

DI void gla_p1_unit(const Params& P, int u) {
  char* ws = P.ws;
  const int tid = get_tid(), lane = tid & 63, wid = tid >> 6;
  float* lr_s = (float*)smem_raw;
  float* b_s = (float*)(smem_raw + 4096);
  float* seg_s = (float*)(smem_raw + 4096 + 32768);
  u16* kdT = (u16*)(smem_raw + 4096 + 32768 + 2048);
  int T0, NT, h;
  if (u < 2048) { int sh = u >> 8, c = u & 255; h = sh & 3; T0 = (sh >> 2) * 16384 + c * 64; NT = 64; }
  else { int su = u - 2048; h = su & 3; T0 = MP + (su >> 2) * 32; NT = 32; }
  const float* LR = (const float*)(ws + W_LR);
  if (tid < 256) {
    int t = tid >> 2;
    f32x4 v = f32x4{0.f, 0.f, 0.f, 0.f};
    if (t < NT) v = *(const f32x4*)(LR + (size_t)(T0 + t) * 16 + (tid & 3) * 4);
    *(f32x4*)(lr_s + tid * 4) = v;
  }
  __syncthreads();
  {
    const int col = tid & 127, tq = tid >> 7;
    float w[16];
#pragma unroll
    for (int r = 0; r < 16; ++r) w[r] = P.w_gu[r * 512 + h * 128 + col];
    const float bias = P.b_gate[h * 128 + col];
    float run = 0.f;
#pragma unroll 4
    for (int tt = 0; tt < 16; ++tt) {
      const int t = tq * 16 + tt;
      float x = bias;
#pragma unroll
      for (int r4 = 0; r4 < 4; ++r4) {
        f32x4 l4 = *(const f32x4*)(lr_s + t * 16 + r4 * 4);
        x += l4[0] * w[r4 * 4] + l4[1] * w[r4 * 4 + 1] + l4[2] * w[r4 * 4 + 2] + l4[3] * w[r4 * 4 + 3];
      }
      float g = (fminf(x, 0.f) - __logf(1.f + __expf(-fabsf(x)))) * (1.f / 16.f);
      if (t >= NT) g = 0.f;
      run += g;
      b_s[t * 128 + col] = run;
    }
    seg_s[tq * 128 + col] = run;
  }
  __syncthreads();
  {
    u16* Q1 = (u16*)(ws + W_Q1);
    u16* K1 = (u16*)(ws + W_K1);
    float* DEC = (float*)(ws + W_DEC);
#pragma unroll
    for (int i = 0; i < 2; ++i) {
      const int e = tid + i * 512, t = e >> 4, c8 = (e & 15) * 8, tq = t >> 4;
      float bb[8], bl[8];
#pragma unroll
      for (int j = 0; j < 8; ++j) {
        float s0 = seg_s[c8 + j], s1 = seg_s[128 + c8 + j], s2 = seg_s[256 + c8 + j], s3 = seg_s[384 + c8 + j];
        float pre = (tq > 0 ? s0 : 0.f) + (tq > 1 ? s1 : 0.f) + (tq > 2 ? s2 : 0.f);
        bb[j] = b_s[t * 128 + c8 + j] + pre;
        bl[j] = s0 + s1 + s2 + s3;
      }
      u32x4 qv = u32x4{0u, 0u, 0u, 0u}, kv = u32x4{0u, 0u, 0u, 0u};
      const size_t off = (size_t)(T0 + t) * 512 + h * 128 + c8;
      if (t < NT) { qv = *(const u32x4*)(Q1 + off); kv = *(const u32x4*)(K1 + off); }
      u32x4 qo, ko;
      float kd[8];
#pragma unroll
      for (int jj = 0; jj < 4; ++jj) {
        float q0 = bflo(qv[jj]), q1 = bfhi(qv[jj]), k0 = bflo(kv[jj]), k1 = bfhi(kv[jj]);
        float e0 = __expf(bb[2 * jj]), e1 = __expf(bb[2 * jj + 1]);
        float i0 = __expf(-bb[2 * jj]), i1 = __expf(-bb[2 * jj + 1]);
        qo[jj] = pk_bf16(q0 * e0, q1 * e1);
        ko[jj] = pk_bf16(k0 * i0, k1 * i1);
        kd[2 * jj] = k0 * __expf(bl[2 * jj] - bb[2 * jj]);
        kd[2 * jj + 1] = k1 * __expf(bl[2 * jj + 1] - bb[2 * jj + 1]);
      }
      if (t < NT) { *(u32x4*)(Q1 + off) = qo; *(u32x4*)(K1 + off) = ko; }
#pragma unroll
      for (int j = 0; j < 8; ++j) kdT[(c8 + j) * 72 + t] = f2bf(kd[j]);
      if (t == 0) {
#pragma unroll
        for (int j = 0; j < 8; ++j) DEC[(size_t)u * 128 + c8 + j] = __expf(bl[j]);
      }
    }
  }
  __syncthreads();
  {
    const int mt = wid & 3, ng = wid >> 2, l31 = lane & 31, hf = lane >> 5;
    bf16x8 a[4];
#pragma unroll
    for (int ks = 0; ks < 4; ++ks) a[ks] = *(const bf16x8*)(kdT + (mt * 32 + l31) * 72 + ks * 16 + hf * 8);
    const u16* VT1 = (const u16*)(ws + W_VT1) + (size_t)u * 16384;
    float* U = (float*)(ws + W_U) + (size_t)u * 32768;
#pragma unroll
    for (int q = 0; q < 4; ++q) {
      const int ntile = ng * 4 + q;
      f32x16 c;
#pragma unroll
      for (int i = 0; i < 16; ++i) c[i] = 0.f;
#pragma unroll
      for (int ks = 0; ks < 4; ++ks) {
        bf16x8 bfr = *(const bf16x8*)(VT1 + (ntile * 32 + l31) * 64 + ks * 16 + hf * 8);
        c = __builtin_amdgcn_mfma_f32_32x32x16_bf16(a[ks], bfr, c, 0, 0, 0);
      }
#pragma unroll
      for (int g = 0; g < 4; ++g) {
        f32x4 o = f32x4{c[4 * g], c[4 * g + 1], c[4 * g + 2], c[4 * g + 3]};
        *(f32x4*)(U + ((size_t)((ntile * 8 + mt * 2 + (g >> 1)) * 64 + (g & 1) * 32 + l31)) * 8 + 4 * hf) = o;
      }
    }
  }
  __syncthreads();
}

DI void swa_unit(const Params& P, const u16* __restrict__ kb, const u16* __restrict__ vb, const int vstride,
                 const int pos0, const int kt_start, const int nkt, const int T0, const int kvh, const int g,
                 const int tofs) {
  char* ws = P.ws;
  const int lane = get_tid() & 63, l31 = lane & 31, hf = lane >> 5;
  const u16* Q2 = (const u16*)(ws + W_Q2);
  const int hc = kvh * 256 + g * 64;
  const size_t qrow = (size_t)(T0 + tofs + l31);
  bf16x8 qf[4];
#pragma unroll
  for (int ks = 0; ks < 4; ++ks) qf[ks] = *(const bf16x8*)(Q2 + qrow * 1024 + hc + ks * 16 + hf * 8);
  f32x16 s[6];
#pragma unroll
  for (int kt = 0; kt < 6; ++kt) {
#pragma unroll
    for (int i = 0; i < 16; ++i) s[kt][i] = -1e30f;
    if (kt >= kt_start && kt < nkt) {
      f32x16 c;
#pragma unroll
      for (int i = 0; i < 16; ++i) c[i] = 0.f;
      const u16* kp = kb + (size_t)(pos0 + kt * 32 + l31) * 64 + hf * 8;
#pragma unroll
      for (int ks = 0; ks < 4; ++ks) {
        bf16x8 kf = *(const bf16x8*)(kp + ks * 16);
        c = __builtin_amdgcn_mfma_f32_32x32x16_bf16(kf, qf[ks], c, 0, 0, 0);
      }
      s[kt] = c;
    }
  }
  const float sink = P.sinks[kvh * 4 + g];
  float mx = sink;
#pragma unroll
  for (int kt = 0; kt < 6; ++kt)
#pragma unroll
    for (int i = 0; i < 16; ++i) mx = fmaxf(mx, s[kt][i]);
  mx = fmaxf(mx, __shfl_xor(mx, 32));
  float sum = 0.f;
#pragma unroll
  for (int kt = 0; kt < 6; ++kt)
#pragma unroll
    for (int i = 0; i < 16; ++i) {
      float p = __expf(s[kt][i] - mx);
      s[kt][i] = p;
      sum += p;
    }
  sum += __shfl_xor(sum, 32);
  sum += __expf(sink - mx);
  const float inv = 1.f / sum;
  f32x16 o[2];
#pragma unroll
  for (int nt2 = 0; nt2 < 2; ++nt2)
#pragma unroll
    for (int i = 0; i < 16; ++i) o[nt2][i] = 0.f;
#pragma unroll
  for (int kt = 0; kt < 6; ++kt) {
    if (kt >= kt_start && kt < nkt) {
#pragma unroll
      for (int sub = 0; sub < 2; ++sub) {
        union { bf16x8 v; unsigned w[4]; } pf;
#pragma unroll
        for (int jj = 0; jj < 4; ++jj)
          pf.w[jj] = pk_bf16(s[kt][sub * 8 + 2 * jj] * inv, s[kt][sub * 8 + 2 * jj + 1] * inv);
        const int key0 = pos0 + kt * 32 + sub * 16 + 4 * hf;
#pragma unroll
        for (int nt2 = 0; nt2 < 2; ++nt2) {
          const u16* vp = vb + (size_t)(nt2 * 32 + l31) * vstride + key0;
          union { bf16x8 v; u32x2 h2[2]; } vf;
          vf.h2[0] = *(const u32x2*)(vp);
          vf.h2[1] = *(const u32x2*)(vp + 8);
          o[nt2] = __builtin_amdgcn_mfma_f32_32x32x16_bf16(pf.v, vf.v, o[nt2], 0, 0, 0);
        }
      }
    }
  }
  const u16* Z2 = (const u16*)(ws + W_Z2);
  u16* MIX = (u16*)(ws + W_MIX);
#pragma unroll
  for (int nt2 = 0; nt2 < 2; ++nt2)
#pragma unroll
    for (int i = 0; i < 16; ++i) {
      const int t = (i & 3) + 8 * (i >> 2) + 4 * hf;
      const size_t row = (size_t)(T0 + tofs + t);
      const int col = hc + nt2 * 32 + l31;
      float z = bf2f(Z2[row * 1024 + col]);
      MIX[row * 2048 + 1024 + col] = f2bf(o[nt2][i] * siluf_(z));
    }
}

DI void phase_mix1() {
  const Params P = load_params();
  char* ws = P.ws;
  const int wid = get_tid() >> 6;
  const int total = NU + 2048 + 32;
  for (int item = blockIdx.x; item < total; item += gridDim.x) {
    if (item < NU) {
      gla_p1_unit(P, item);
    } else if (item < NU + 2048) {
      const int q = item - NU, kvh = q & 3, c = (q >> 2) & 255, b = q >> 10;
      const u16* kb = (const u16*)(ws + W_K2P) + (size_t)(b * 4 + kvh) * 16384 * 64;
      const u16* vb = (const u16*)(ws + W_VT2P) + (size_t)(b * 4 + kvh) * 64 * 16384;
      const int kt_start = c == 0 ? 4 : (c == 1 ? 2 : 0);
      swa_unit(P, kb, vb, 16384, c * 64 - 128, kt_start, 6, b * 16384 + c * 64, kvh, wid >> 1, (wid & 1) * 32);
    } else {
      const int q = item - NU - 2048, kvh = q & 3, sb = q >> 2;
      if (wid < 4) {
        const u16* kb = (const u16*)(ws + W_K2S) + (size_t)(sb * 4 + kvh) * 160 * 64;
        const u16* vb = (const u16*)(ws + W_VT2S) + (size_t)(sb * 4 + kvh) * 64 * 160;
        swa_unit(P, kb, vb, 160, 0, 0, 5, MP + sb * 32, kvh, wid, 0);
      }
    }
  }
}

DI void phase_scan() {
  const Params P = load_params();
  char* ws = P.ws;
  const float* U = (const float*)(ws + W_U);
  u16* S = (u16*)(ws + W_S);
  const float* DEC = (const float*)(ws + W_DEC);
  const int gtid = blockIdx.x * 512 + get_tid(), gsz = gridDim.x * 512;
  for (int item = gtid; item < 8 * 16384; item += gsz) {
    const int sh = item >> 14, q2 = item & 16383;
    const int j0 = (q2 & 3) * 2, ln = (q2 >> 2) & 63, ks = (q2 >> 8) & 7, ntl = q2 >> 11;
    const int dk = ks * 16 + (ln >> 5) * 8 + j0, dv = ntl * 32 + (ln & 31);
    float s0 = 0.f, s1 = 0.f;
    const size_t ubase = (size_t)sh * 256 * 32768 + (size_t)q2 * 2;
    const size_t dbase = (size_t)sh * 256 * 128 + dk;
    for (int c0 = 0; c0 < 256; c0 += 8) {
      float2 uu[8], dd[8];
#pragma unroll
      for (int i = 0; i < 8; ++i) {
        uu[i] = *(const float2*)(U + ubase + (size_t)(c0 + i) * 32768);
        dd[i] = *(const float2*)(DEC + dbase + (size_t)(c0 + i) * 128);
      }
#pragma unroll
      for (int i = 0; i < 8; ++i) {
        *(unsigned*)(S + ubase + (size_t)(c0 + i) * 32768) = pk_bf16(s0, s1);
        s0 = dd[i].x * s0 + uu[i].x;
        s1 = dd[i].y * s1 + uu[i].y;
      }
    }
    float* o = P.out + O_SGP + (size_t)sh * 32768 + (size_t)dk * 256 + dv;
    o[0] = s0;
    o[256] = s1;
  }
  for (int item = gtid; item < 32 * 16384; item += gsz) {
    const int su = item >> 14, q2 = item & 16383;
    const int j0 = (q2 & 3) * 2, ln = (q2 >> 2) & 63, ks = (q2 >> 8) & 7, ntl = q2 >> 11;
    const int dk = ks * 16 + (ln >> 5) * 8 + j0, dv = ntl * 32 + (ln & 31);
    const float2 uu = *(const float2*)(U + (size_t)(2048 + su) * 32768 + (size_t)q2 * 2);
    const float2 dd = *(const float2*)(DEC + (size_t)(2048 + su) * 128 + dk);
    const float* s0p = P.state + (size_t)su * 32768 + (size_t)dk * 256 + dv;
    float* o = P.out + O_SGS + (size_t)su * 32768 + (size_t)dk * 256 + dv;
    o[0] = dd.x * s0p[0] + uu.x;
    o[256] = dd.y * s0p[256] + uu.y;
  }
}

DI void gla_p3_unit(const Params& P, int u) {
  char* ws = P.ws;
  const int tid = get_tid(), lane = tid & 63, w = tid >> 6, l31 = lane & 31, hf = lane >> 5;
  int T0, NT, h;
  if (u < 2048) { int sh = u >> 8, c = u & 255; h = sh & 3; T0 = (sh >> 2) * 16384 + c * 64; NT = 64; }
  else { int su = u - 2048; h = su & 3; T0 = MP + (su >> 2) * 32; NT = 32; }
  const u16* Q1 = (const u16*)(ws + W_Q1);
  const u16* K1 = (const u16*)(ws + W_K1);
  const u16* VT1 = (const u16*)(ws + W_VT1) + (size_t)u * 16384;
  const u16* S = (const u16*)(ws + W_S) + (size_t)u * 32768;
  float* o_s = (float*)smem_raw;
  const bool hi_ok = NT > 32;
  bf16x8 qf[2][8];
#pragma unroll
  for (int ti = 0; ti < 2; ++ti)
#pragma unroll
    for (int ks = 0; ks < 8; ++ks) {
      bf16x8 z;
#pragma unroll
      for (int j = 0; j < 8; ++j) z[j] = 0;
      if (ti == 0 || hi_ok) z = *(const bf16x8*)(Q1 + (size_t)(T0 + ti * 32 + l31) * 512 + h * 128 + ks * 16 + hf * 8);
      qf[ti][ks] = z;
    }
  f32x16 at00, at01, at11;
#pragma unroll
  for (int i = 0; i < 16; ++i) { at00[i] = 0.f; at01[i] = 0.f; at11[i] = 0.f; }
#pragma unroll
  for (int ks = 0; ks < 8; ++ks) {
    bf16x8 kf = *(const bf16x8*)(K1 + (size_t)(T0 + l31) * 512 + h * 128 + ks * 16 + hf * 8);
    at00 = __builtin_amdgcn_mfma_f32_32x32x16_bf16(kf, qf[0][ks], at00, 0, 0, 0);
    at01 = __builtin_amdgcn_mfma_f32_32x32x16_bf16(kf, qf[1][ks], at01, 0, 0, 0);
  }
  if (hi_ok) {
#pragma unroll
    for (int ks = 0; ks < 8; ++ks) {
      bf16x8 kf = *(const bf16x8*)(K1 + (size_t)(T0 + 32 + l31) * 512 + h * 128 + ks * 16 + hf * 8);
      at11 = __builtin_amdgcn_mfma_f32_32x32x16_bf16(kf, qf[1][ks], at11, 0, 0, 0);
    }
  }
  union PF { bf16x8 v; unsigned wd[4]; };
  PF p00[2], p01[2], p11[2];
#pragma unroll
  for (int sub = 0; sub < 2; ++sub)
#pragma unroll
    for (int jj = 0; jj < 4; ++jj) {
      const int i0 = sub * 8 + 2 * jj, i1 = i0 + 1;
      const int s0 = (i0 & 3) + 8 * (i0 >> 2) + 4 * hf, s1 = (i1 & 3) + 8 * (i1 >> 2) + 4 * hf;
      p00[sub].wd[jj] = pk_bf16(s0 <= l31 ? at00[i0] : 0.f, s1 <= l31 ? at00[i1] : 0.f);
      p01[sub].wd[jj] = pk_bf16(at01[i0], at01[i1]);
      p11[sub].wd[jj] = pk_bf16(s0 <= l31 ? at11[i0] : 0.f, s1 <= l31 ? at11[i1] : 0.f);
    }
  f32x16 o0, o1;
#pragma unroll
  for (int i = 0; i < 16; ++i) { o0[i] = 0.f; o1[i] = 0.f; }
  {
    const u16* vp = VT1 + (size_t)(w * 32 + l31) * 64 + 4 * hf;
#pragma unroll
    for (int sub = 0; sub < 2; ++sub) {
      union { bf16x8 v; u32x2 h2[2]; } vf;
      vf.h2[0] = *(const u32x2*)(vp + sub * 16);
      vf.h2[1] = *(const u32x2*)(vp + sub * 16 + 8);
      o0 = __builtin_amdgcn_mfma_f32_32x32x16_bf16(p00[sub].v, vf.v, o0, 0, 0, 0);
      o1 = __builtin_amdgcn_mfma_f32_32x32x16_bf16(p01[sub].v, vf.v, o1, 0, 0, 0);
    }
#pragma unroll
    for (int sub = 0; sub < 2; ++sub) {
      union { bf16x8 v; u32x2 h2[2]; } vf;
      vf.h2[0] = *(const u32x2*)(vp + 32 + sub * 16);
      vf.h2[1] = *(const u32x2*)(vp + 32 + sub * 16 + 8);
      o1 = __builtin_amdgcn_mfma_f32_32x32x16_bf16(p11[sub].v, vf.v, o1, 0, 0, 0);
    }
  }
#pragma unroll
  for (int ks = 0; ks < 8; ++ks) {
    bf16x8 sf = *(const bf16x8*)(S + ((size_t)(w * 8 + ks) * 64 + lane) * 8);
    o0 = __builtin_amdgcn_mfma_f32_32x32x16_bf16(qf[0][ks], sf, o0, 0, 0, 0);
    o1 = __builtin_amdgcn_mfma_f32_32x32x16_bf16(qf[1][ks], sf, o1, 0, 0, 0);
  }
#pragma unroll
  for (int i = 0; i < 16; ++i) {
    const int t = (i & 3) + 8 * (i >> 2) + 4 * hf;
    o_s[t * 260 + w * 32 + l31] = o0[i];
    o_s[(32 + t) * 260 + w * 32 + l31] = o1[i];
  }
  __syncthreads();
  {
    const int row = tid >> 3, seg = tid & 7;
    f32x4 v[8];
    float ss = 0.f;
#pragma unroll
    for (int i = 0; i < 8; ++i) {
      v[i] = *(const f32x4*)(o_s + row * 260 + seg * 32 + i * 4);
      ss += v[i][0] * v[i][0] + v[i][1] * v[i][1] + v[i][2] * v[i][2] + v[i][3] * v[i][3];
    }
    ss += __shfl_xor(ss, 1);
    ss += __shfl_xor(ss, 2);
    ss += __shfl_xor(ss, 4);
    const float rstd = rsqrtf(ss * (1.f / 256.f) + EPS);
    if (row < NT) {
      const size_t trow = (size_t)(T0 + row);
      const u16* zp = (const u16*)(ws + W_Z1) + trow * 1024 + h * 256 + seg * 32;
      u16* mp = (u16*)(ws + W_MIX) + trow * 2048 + h * 256 + seg * 32;
      const float* gg = P.g_gla + seg * 32;
#pragma unroll
      for (int i2 = 0; i2 < 4; ++i2) {
        u32x4 zz = *(const u32x4*)(zp + i2 * 8);
        f32x4 g0 = *(const f32x4*)(gg + i2 * 8), g1 = *(const f32x4*)(gg + i2 * 8 + 4);
        f32x4 a = v[2 * i2], bq = v[2 * i2 + 1];
        u32x4 oo;
        oo[0] = pk_bf16(a[0] * rstd * g0[0] * siluf_(bflo(zz[0])), a[1] * rstd * g0[1] * siluf_(bfhi(zz[0])));
        oo[1] = pk_bf16(a[2] * rstd * g0[2] * siluf_(bflo(zz[1])), a[3] * rstd * g0[3] * siluf_(bfhi(zz[1])));
        oo[2] = pk_bf16(bq[0] * rstd * g1[0] * siluf_(bflo(zz[2])), bq[1] * rstd * g1[1] * siluf_(bfhi(zz[2])));
        oo[3] = pk_bf16(bq[2] * rstd * g1[2] * siluf_(bflo(zz[3])), bq[3] * rstd * g1[3] * siluf_(bfhi(zz[3])));
        *(u32x4*)(mp + i2 * 8) = oo;
      }
    }
  }
  __syncthreads();
}

DI void phase_p3() {
  const Params P = load_params();
  for (int u = blockIdx.x; u < NU; u += gridDim.x) gla_p3_unit(P, u);
}

DI void phase_outproj() {
  const Params P = load_params();
  char* ws = P.ws;
  const u16* MIX = (const u16*)(ws + W_MIX);
  const u16* WOUT = (const u16*)(ws + W_WOUT);
  u16* HB = (u16*)(ws + W_HB);
  float* RSQH = (float*)(ws + W_RSQH);
  const int tid = get_tid();
  const int wid = __builtin_amdgcn_readfirstlane(tid >> 6), wr = wid >> 2, wc = wid & 3;
  f32x4 acc[2][2][4][2];
  int pm, pn;
  for (int it = 0; next_tile(it, 129, 8, pm, pn); ++it) {
    const int brow = pm * 256, bcol = pn * 256;
    gemm_kloop(MIX, WOUT, 2048, brow, bcol, acc, tid);
    int te = tid;
    asm volatile("" : "+v"(te));
    const int fr = te & 15, fq = (te >> 4) & 3;
#pragma unroll
    for (int ai = 0; ai < 2; ++ai)
#pragma unroll
      for (int m = 0; m < 4; ++m) {
        const int row = brow + ai * 128 + wr * 64 + m * 16 + fr;
        const float* xr = row < MP ? P.x_p + (size_t)row * 2048 : P.x_s + (size_t)(row - MP) * 2048;
        float ss = 0.f;
#pragma unroll
        for (int bj = 0; bj < 2; ++bj)
#pragma unroll
          for (int n = 0; n < 2; ++n) {
            const int col = bcol + bj * 128 + wc * 32 + n * 16 + fq * 4;
            f32x4 hv = acc[ai][bj][m][n] + *(const f32x4*)(xr + col);
            ss += hv[0] * hv[0] + hv[1] * hv[1] + hv[2] * hv[2] + hv[3] * hv[3];
            *(f32x4*)(P.out + O_Y + (size_t)row * 2048 + col) = hv;
            store_bf4(HB + (size_t)row * 2048 + col, hv);
          }
        ss += __shfl_xor(ss, 16);
        ss += __shfl_xor(ss, 32);
        if (fq == 0) unsafeAtomicAdd(RSQH + row, ss);
        __builtin_amdgcn_sched_barrier(0);
      }
  }
}

DI void phase_ple() {
  const Params P = load_params();
  char* ws = P.ws;
  const u16* HB = (const u16*)(ws + W_HB);
  const u16* WG = (const u16*)(ws + W_WG);
  const u16* PB = (const u16*)(ws + W_PB);
  const u16* WP = (const u16*)(ws + W_WP);
  const float* RSQH = (const float*)(ws + W_RSQH);
  float* RSQH2 = (float*)(ws + W_RSQH2);
  u32x4* stash = (u32x4*)(ws + W_STASH + (size_t)blockIdx.x * 131072);
  const int tid = get_tid();
  const int wid = __builtin_amdgcn_readfirstlane(tid >> 6), wr = wid >> 2, wc = wid & 3;
  f32x4 acc[2][2][4][2];
  int pm, pn;
  for (int it = 0; next_tile(it, 129, 8, pm, pn); ++it) {
    const int brow = pm * 256, bcol = pn * 256;
    gemm_kloop(HB, WG, 2048, brow, bcol, acc, tid);
    int te = tid;
    asm volatile("" : "+v"(te));
    const int fr = te & 15, fq = (te >> 4) & 3;
#pragma unroll
    for (int ai = 0; ai < 2; ++ai)
#pragma unroll
      for (int m = 0; m < 4; ++m) {
        const int row = brow + ai * 128 + wr * 64 + m * 16 + fr;
        const float rs = rsqrtf(RSQH[row] * (1.f / 2048.f) + EPS);
#pragma unroll
        for (int bj = 0; bj < 2; ++bj) {
          f32x4 a = acc[ai][bj][m][0], bq = acc[ai][bj][m][1];
          u32x4 o;
          o[0] = pk_bf16(sigmoidf_(a[0] * rs), sigmoidf_(a[1] * rs));
          o[1] = pk_bf16(sigmoidf_(a[2] * rs), sigmoidf_(a[3] * rs));
          o[2] = pk_bf16(sigmoidf_(bq[0] * rs), sigmoidf_(bq[1] * rs));
          o[3] = pk_bf16(sigmoidf_(bq[2] * rs), sigmoidf_(bq[3] * rs));
          stash[(size_t)((ai * 4 + m) * 2 + bj) * 512 + te] = o;
        }
        __builtin_amdgcn_sched_barrier(0);
      }
    gemm_kloop(PB, WP, 256, brow, bcol, acc, tid);
    int te2 = tid;
    asm volatile("" : "+v"(te2));
    const int fr2 = te2 & 15, fq2 = (te2 >> 4) & 3;
#pragma unroll
    for (int ai = 0; ai < 2; ++ai)
#pragma unroll
      for (int m = 0; m < 4; ++m) {
        const int row = brow + ai * 128 + wr * 64 + m * 16 + fr2;
        float ss = 0.f;
#pragma unroll
        for (int bj = 0; bj < 2; ++bj) {
          u32x4 gt = stash[(size_t)((ai * 4 + m) * 2 + bj) * 512 + te2];
#pragma unroll
          for (int n = 0; n < 2; ++n) {
            const int col = bcol + bj * 128 + wc * 32 + n * 16 + fq2 * 4;
            float* yp = P.out + O_Y + (size_t)row * 2048 + col;
            f32x4 hv = *(const f32x4*)yp;
            f32x4 pp = acc[ai][bj][m][n];
            f32x4 gv = f32x4{bflo(gt[2 * n]), bfhi(gt[2 * n]), bflo(gt[2 * n + 1]), bfhi(gt[2 * n + 1])};
            f32x4 h2 = hv + gv * pp;
            ss += h2[0] * h2[0] + h2[1] * h2[1] + h2[2] * h2[2] + h2[3] * h2[3];
            *(f32x4*)yp = h2;
          }
        }
        ss += __shfl_xor(ss, 16);
        ss += __shfl_xor(ss, 32);
        if (fq2 == 0) unsafeAtomicAdd(RSQH2 + row, ss);
        __builtin_amdgcn_sched_barrier(0);
      }
  }
}

DI void phase_final() {
  const Params P = load_params();
  const float* RSQH2 = (const float*)(P.ws + W_RSQH2);
  const size_t n4 = (size_t)MT * 512;
  for (size_t i = (size_t)blockIdx.x * 512 + get_tid(); i < n4; i += (size_t)gridDim.x * 512) {
    const int row = (int)(i >> 9), c4 = (int)(i & 511);
    const float rs = rsqrtf(RSQH2[row] * (1.f / 2048.f) + EPS);
    f32x4 v = ((const f32x4*)(P.out + O_Y))[i];
    f32x4 g = ((const f32x4*)P.g_final)[c4];
    ((f32x4*)(P.out + O_Y))[i] = v * rs * g;
  }
}

__global__ void __launch_bounds__(512, 2) hymba_megakernel(Params Pk) {
  cg::grid_group grid = cg::this_grid();
  const int ph_lo = Pk.ph_lo, ph_hi = Pk.ph_hi;
#define RUN_PHASE(ph, call)                  \
  if (ph_lo <= ph && ph < ph_hi) {           \
    if (ph > ph_lo) grid.sync();             \
    call;                                    \
  }
  RUN_PHASE(0, phase_prep())
  RUN_PHASE(1, phase_inproj())
  RUN_PHASE(2, phase_mix1())
  RUN_PHASE(3, phase_scan())
  RUN_PHASE(4, phase_p3())
  RUN_PHASE(5, phase_outproj())
  RUN_PHASE(6, phase_ple())
  RUN_PHASE(7, phase_final())
}

extern "C" void kernel_launch(void* const* d_in, const int* in_sizes, int n_in, void* d_out, int out_size, void* d_ws,
                              size_t ws_size, hipStream_t stream) {
  static int grid_blocks = 0;
  if (!grid_blocks) {
    hipFuncSetAttribute((const void*)hymba_megakernel, hipFuncAttributeMaxDynamicSharedMemorySize, SHM_B);
    int dev = 0, cus = 0, per_cu = 0;
    hipGetDevice(&dev);
    hipDeviceGetAttribute(&cus, hipDeviceAttributeMultiprocessorCount, dev);
    hipOccupancyMaxActiveBlocksPerMultiprocessor(&per_cu, hymba_megakernel, 512, SHM_B);
    if (per_cu < 1) per_cu = 1;
    if (per_cu > 1) per_cu = 1;
    grid_blocks = cus * per_cu;
  }
  Params p{};
  p.x_p = (const float*)d_in[0]; p.x_s = (const float*)d_in[1]; p.p_p = (const float*)d_in[2];
  p.p_s = (const float*)d_in[3]; p.state = (const float*)d_in[4]; p.ck = (const float*)d_in[5];
  p.cv = (const float*)d_in[6]; p.g_mix = (const float*)d_in[7]; p.w_in = (const float*)d_in[8];
  p.w_gu = (const float*)d_in[9]; p.b_gate = (const float*)d_in[10]; p.g_gla = (const float*)d_in[11];
  p.sinks = (const float*)d_in[12]; p.w_out = (const float*)d_in[13]; p.g_ple = (const float*)d_in[14];
  p.w_pg = (const float*)d_in[15]; p.w_pp = (const float*)d_in[16]; p.g_final = (const float*)d_in[17];
  p.out = (float*)d_out;
  p.ws = (char*)d_ws;
  p.ph_lo = 0;
  p.ph_hi = 8;
  void* args[] = {&p};
  hipError_t e = hipLaunchCooperativeKernel((const void*)hymba_megakernel, dim3(grid_blocks), dim3(512), args, SHM_B, stream);
  if (e != hipSuccess) fprintf(stderr, "cooperative launch failed: %s (grid %d)\n", hipGetErrorString(e), grid_blocks);
}
```

```cpp
#include <hip/hip_runtime.h>
#include <hip/hip_cooperative_groups.h>
#include <cstdio>
namespace cg = cooperative_groups;

typedef unsigned short u16;
using bf16x8 = __attribute__((ext_vector_type(8))) short;
using f32x4 = __attribute__((ext_vector_type(4))) float;
using f32x16 = __attribute__((ext_vector_type(16))) float;
using u32x2 = __attribute__((ext_vector_type(2))) unsigned;
using u32x4 = __attribute__((ext_vector_type(4))) unsigned;

#define DI __device__ __forceinline__

constexpr int MP = 32768, MS = 256, MT = MP + MS;
constexpr int LSEQ = 16384, DM = 2048;
constexpr int NIN = 5888;
constexpr int NU = 2080;
constexpr float EPS = 1e-6f;

constexpr size_t O_Y = 0;
constexpr size_t O_SGP = (size_t)MT * 2048;
constexpr size_t O_KP = O_SGP + 262144;
constexpr size_t O_VP = O_KP + 65536;
constexpr size_t O_SGS = O_VP + 65536;
constexpr size_t O_KS = O_SGS + 1048576;
constexpr size_t O_VS = O_KS + 65536;

constexpr size_t al256(size_t x) { return (x + 255) & ~(size_t)255; }
constexpr size_t W_XB = 0;
constexpr size_t W_PB = W_XB + al256((size_t)MT * 2048 * 2);
constexpr size_t W_WIN = W_PB + al256((size_t)MT * 256 * 2);
constexpr size_t W_WOUT = W_WIN + al256((size_t)NIN * 2048 * 2);
constexpr size_t W_WG = W_WOUT + al256((size_t)2048 * 2048 * 2);
constexpr size_t W_WP = W_WG + al256((size_t)2048 * 2048 * 2);
constexpr size_t W_RSTDX = W_WP + al256((size_t)2048 * 256 * 2);
constexpr size_t W_Q1 = W_RSTDX + al256((size_t)MT * 4);
constexpr size_t W_K1 = W_Q1 + al256((size_t)MT * 512 * 2);
constexpr size_t W_VT1 = W_K1 + al256((size_t)MT * 512 * 2);
constexpr size_t W_Z1 = W_VT1 + al256((size_t)NU * 256 * 64 * 2);
constexpr size_t W_Q2 = W_Z1 + al256((size_t)MT * 1024 * 2);
constexpr size_t W_K2P = W_Q2 + al256((size_t)MT * 1024 * 2);
constexpr size_t W_K2S = W_K2P + al256((size_t)8 * 16384 * 64 * 2);
constexpr size_t W_VT2P = W_K2S + al256((size_t)32 * 160 * 64 * 2);
constexpr size_t W_VT2S = W_VT2P + al256((size_t)8 * 64 * 16384 * 2);
constexpr size_t W_Z2 = W_VT2S + al256((size_t)32 * 64 * 160 * 2);
constexpr size_t W_LR = W_Z2 + al256((size_t)MT * 1024 * 2);
constexpr size_t W_U = W_LR + al256((size_t)MT * 16 * 4);
constexpr size_t W_S = W_U + al256((size_t)NU * 32768 * 4);
constexpr size_t W_DEC = W_S + al256((size_t)NU * 32768 * 2);
constexpr size_t W_RSQH = W_DEC + al256((size_t)NU * 128 * 4);
constexpr size_t W_RSQH2 = W_RSQH + al256((size_t)MT * 4);
constexpr size_t W_END = W_RSQH2 + al256((size_t)MT * 4);
constexpr size_t W_MIX = W_XB;
constexpr size_t W_H2B = W_XB;
constexpr size_t W_HB = W_Q1;
constexpr size_t W_STASH = W_Z1;
static_assert(W_HB + (size_t)MT * 2048 * 2 <= W_Z1, "HB alias overflow");
static_assert(W_END <= (size_t)1073741824, "workspace too large");

struct Params {
  const float *x_p, *x_s, *p_p, *p_s, *state, *ck, *cv, *g_mix, *w_in, *w_gu, *b_gate, *g_gla, *sinks, *w_out,
      *g_ple, *w_pg, *w_pp, *g_final;
  float* out;
  char* ws;
  int ph_lo, ph_hi;
};

extern __shared__ __attribute__((aligned(16))) unsigned char smem_raw[];

typedef const __attribute__((address_space(4))) Params* KParamsPtr;
__device__ __forceinline__ Params load_params() {
  KParamsPtr kp = (KParamsPtr)__builtin_amdgcn_kernarg_segment_ptr();
  asm volatile("" : "+s"(kp));
  Params r;
  r.x_p = kp->x_p; r.x_s = kp->x_s; r.p_p = kp->p_p; r.p_s = kp->p_s; r.state = kp->state; r.ck = kp->ck; r.cv = kp->cv;
  r.g_mix = kp->g_mix; r.w_in = kp->w_in; r.w_gu = kp->w_gu; r.b_gate = kp->b_gate; r.g_gla = kp->g_gla;
  r.sinks = kp->sinks; r.w_out = kp->w_out; r.g_ple = kp->g_ple; r.w_pg = kp->w_pg; r.w_pp = kp->w_pp;
  r.g_final = kp->g_final; r.out = kp->out; r.ws = kp->ws; r.ph_lo = kp->ph_lo; r.ph_hi = kp->ph_hi;
  return r;
}

DI unsigned pk_bf16(float a, float b) {
  unsigned r;
  asm("v_cvt_pk_bf16_f32 %0, %1, %2" : "=v"(r) : "v"(a), "v"(b));
  return r;
}
DI u16 f2bf(float a) { return (u16)(pk_bf16(a, 0.f) & 0xffffu); }
DI float bf2f(u16 v) { return __uint_as_float(((unsigned)v) << 16); }
DI float bflo(unsigned v) { return __uint_as_float(v << 16); }
DI float bfhi(unsigned v) { return __uint_as_float(v & 0xffff0000u); }
DI float sigmoidf_(float x) { return 1.f / (1.f + __expf(-x)); }
DI float siluf_(float x) { return x / (1.f + __expf(-x)); }
DI int get_tid() {
  int t = threadIdx.x;
  asm volatile("" : "+v"(t));
  return t;
}
DI float wave_sum(float v) {
#pragma unroll
  for (int o = 32; o >= 1; o >>= 1) v += __shfl_xor(v, o);
  return v;
}

constexpr int BM = 256, BK = 64, HALF = 128, HT = HALF * BK;
constexpr int SHM_B = 8 * HT * 2;

DI int lds_byte(int r, int c) {
  int st = (r >> 4) * 2 + (c >> 5), rr = r & 15, cc = c & 31, ob = rr * 64 + cc * 2;
  return st * 1024 + (ob ^ (((ob >> 9) & 1) << 5));
}
DI void stage_rc(int b, int& R, int& C) {
  int st = b / 1024, sb = b % 1024, swz = sb ^ (((sb >> 9) & 1) << 5);
  R = (st >> 1) * 16 + swz / 64;
  C = (st & 1) * 32 + (swz % 64) / 2;
}

DI void gemm_kloop(const u16* __restrict__ A, const u16* __restrict__ Bt, const int K, const int brow, const int bcol,
                   f32x4 (&acc)[2][2][4][2], const int tid_) {
  u16* shm = (u16*)smem_raw;
#define SA(b, h) (shm + ((b)*2 + (h)) * HT)
#define SB(b, h) (shm + (4 + (b)*2 + (h)) * HT)
#define STAGE(P, BASE, br, kt)                                                                       \
  do {                                                                                               \
    const char* _gb = (const char*)(BASE + ((size_t)(br)*K + (size_t)(kt)*BK));                      \
    asm volatile("" : "+s"(_gb));                                                                    \
    __builtin_amdgcn_global_load_lds((const unsigned*)(_gb + (size_t)so0),                           \
                                     (__attribute__((address_space(3))) unsigned*)((char*)(P) + lw), 16, 0, 0); \
    __builtin_amdgcn_global_load_lds((const unsigned*)(_gb + (size_t)so1),                           \
                                     (__attribute__((address_space(3))) unsigned*)((char*)(P) + lw + 8192), 16, 0, 0); \
  } while (0)
#define LDA(dst, b, h)                                                                               \
  for (int m = 0; m < 4; ++m)                                                                        \
    for (int k = 0; k < 2; ++k)                                                                      \
  dst[m][k] = *reinterpret_cast<const bf16x8*>((char*)SA(b, h) + lds_byte(wr * 64 + m * 16 + fr, k * 32 + fq * 8))
#define LDB(dst, b, h)                                                                               \
  for (int n = 0; n < 2; ++n)                                                                        \
    for (int k = 0; k < 2; ++k)                                                                      \
  dst[n][k] = *reinterpret_cast<const bf16x8*>((char*)SB(b, h) + lds_byte(wc * 32 + n * 16 + fr, k * 32 + fq * 8))
#define MMA(ai, bj, At_, Bt_)                                                                        \
  do {                                                                                               \
    __builtin_amdgcn_s_setprio(1);                                                                   \
    for (int m = 0; m < 4; ++m)                                                                      \
      for (int n = 0; n < 2; ++n)                                                                    \
        for (int k = 0; k < 2; ++k)                                                                  \
          acc[ai][bj][m][n] = __builtin_amdgcn_mfma_f32_16x16x32_bf16(Bt_[n][k], At_[m][k], acc[ai][bj][m][n], 0, 0, 0); \
    __builtin_amdgcn_s_setprio(0);                                                                   \
  } while (0)
#define WAIT_V(n) asm volatile("s_waitcnt vmcnt(" #n ")" ::: "memory")
#define WAIT_L(n) asm volatile("s_waitcnt lgkmcnt(" #n ")" ::: "memory")
#define BAR __builtin_amdgcn_s_barrier()
#define SCHED __builtin_amdgcn_sched_barrier(0)

  const int wid = __builtin_amdgcn_readfirstlane(tid_ >> 6), lane = tid_ & 63, wr = wid >> 2, wc = wid & 3, fr = lane & 15, fq = lane >> 4;
  const int sb0 = tid_ * 16;
  unsigned so0, so1;
  {
    int r_, c_;
    stage_rc(sb0, r_, c_);
    so0 = (unsigned)(r_ * K + c_) * 2u;
    stage_rc(sb0 + 8192, r_, c_);
    so1 = (unsigned)(r_ * K + c_) * 2u;
  }
  const int lw = wid * 1024;
#pragma unroll
  for (int a = 0; a < 2; ++a)
#pragma unroll
    for (int b = 0; b < 2; ++b)
#pragma unroll
      for (int m = 0; m < 4; ++m)
#pragma unroll
        for (int n = 0; n < 2; ++n) acc[a][b][m][n] = f32x4{0.f, 0.f, 0.f, 0.f};
  bf16x8 At[4][2], B0[2][2], B1[2][2];
  const int nt = K / BK;
  STAGE(SB(0, 0), Bt, bcol, 0);
  STAGE(SA(0, 0), A, brow, 0);
  STAGE(SB(0, 1), Bt, bcol + HALF, 0);
  STAGE(SA(0, 1), A, brow + HALF, 0);
  if (wr == 1) BAR;
  WAIT_V(4);
  BAR;
  STAGE(SB(1, 0), Bt, bcol, 1);
  STAGE(SA(1, 0), A, brow, 1);
  STAGE(SB(1, 1), Bt, bcol + HALF, 1);
  WAIT_V(6);
  BAR;
  for (int t = 0; t < nt - 2; t += 2) {
    LDB(B0, 0, 0); SCHED; LDA(At, 0, 0); STAGE(SA(1, 1), A, brow + HALF, t + 1);
    WAIT_L(8); BAR; WAIT_L(0); MMA(0, 0, At, B0); BAR; SCHED;
    LDB(B1, 0, 1); STAGE(SB(0, 0), Bt, bcol, t + 2);
    BAR; WAIT_L(0); MMA(0, 1, At, B1); BAR;
    LDA(At, 0, 1); STAGE(SA(0, 0), A, brow, t + 2);
    BAR; WAIT_L(0); MMA(1, 0, At, B0); BAR; SCHED;
    STAGE(SB(0, 1), Bt, bcol + HALF, t + 2);
    WAIT_V(6); BAR; MMA(1, 1, At, B1); BAR;
    LDB(B0, 1, 0); SCHED; LDA(At, 1, 0); STAGE(SA(0, 1), A, brow + HALF, t + 2);
    WAIT_L(8); BAR; WAIT_L(0); MMA(0, 0, At, B0); BAR; SCHED;
    LDB(B1, 1, 1); STAGE(SB(1, 0), Bt, bcol, t + 3);
    BAR; WAIT_L(0); MMA(0, 1, At, B1); BAR;
    LDA(At, 1, 1); STAGE(SA(1, 0), A, brow, t + 3);
    BAR; WAIT_L(0); MMA(1, 0, At, B0); BAR; SCHED;
    STAGE(SB(1, 1), Bt, bcol + HALF, t + 3);
    WAIT_V(6); BAR; MMA(1, 1, At, B1); BAR;
  }
  {
    LDB(B0, 0, 0); LDA(At, 0, 0); STAGE(SA(1, 1), A, brow + HALF, nt - 1);
    BAR; WAIT_L(0); MMA(0, 0, At, B0); BAR;
    LDB(B1, 0, 1); BAR; WAIT_L(0); MMA(0, 1, At, B1); BAR;
    LDA(At, 0, 1); WAIT_V(4); BAR; WAIT_L(0); MMA(1, 0, At, B0); MMA(1, 1, At, B1); BAR;
  }
  {
    LDB(B0, 1, 0); LDA(At, 1, 0); WAIT_V(2); BAR; WAIT_L(0); MMA(0, 0, At, B0); BAR;
    LDB(B1, 1, 1); WAIT_V(0); BAR; WAIT_L(0); MMA(0, 1, At, B1); BAR;
    LDA(At, 1, 1); BAR; WAIT_L(0); MMA(1, 0, At, B0); MMA(1, 1, At, B1); BAR;
  }
  if (wr == 0) BAR;
#undef SA
#undef SB
#undef STAGE
#undef LDA
#undef LDB
#undef MMA
}

DI bool next_tile(int it, int nM, int nN, int& pm, int& pn) {
  const int nb = gridDim.x, bid = blockIdx.x;
  int tl;
  if ((nb & 7) == 0) {
    int nloc = nb >> 3;
    tl = (it * 8 + (bid & 7)) * nloc + (bid >> 3);
  } else {
    tl = it * nb + bid;
  }
  if (tl >= nM * nN) return false;
  int nig = 8 * nN, g = tl / nig, rem = tl - g * nig, gsz = min(8, nM - g * 8);
  pm = g * 8 + rem % gsz;
  pn = rem / gsz;
  return true;
}

DI void transpose_tile(const float* __restrict__ src, int ldsrc, int K, int n0, int k0, u16* __restrict__ dst,
                       const float* __restrict__ gvec, int mode) {
  float* t = (float*)smem_raw;
  const int tid = get_tid();
  {
    int tn = tid & 63, tk = tid >> 6;
    int np = n0 + tn;
    int scol = np;
    float cs = 1.f;
    bool valid = true;
    if (mode == 1) {
      if (np < 3072) scol = np;
      else if (np < 5632) scol = np + 16;
      else if (np < 5648) scol = 3072 + (np - 5632);
      else valid = false;
      if (np < 512) cs = 0.08838834764831845f;
      else if (np >= 3072 && np < 4096) cs = 0.125f;
    }
#pragma unroll
    for (int i = 0; i < 8; ++i) {
      int k = tk * 8 + i;
      float v = 0.f;
      if (valid) {
        v = src[(size_t)(k0 + k) * ldsrc + scol] * cs;
        if (gvec) v *= gvec[k0 + k];
      }
      t[k * 65 + tn] = v;
    }
  }
  __syncthreads();
  {
    int tk2 = tid & 63, tn2 = tid >> 6;
#pragma unroll
    for (int i = 0; i < 8; ++i) {
      int n = tn2 * 8 + i;
      dst[(size_t)(n0 + n) * K + k0 + tk2] = f2bf(t[tk2 * 65 + n]);
    }
  }
  __syncthreads();
}

DI void phase_prep() {
  const Params P = load_params();
  const int tid = get_tid(), lane = tid & 63, wid = tid >> 6, nb = gridDim.x, bid = blockIdx.x;
  char* ws = P.ws;
  u16* XB = (u16*)(ws + W_XB);
  u16* PB = (u16*)(ws + W_PB);
  float* RSTDX = (float*)(ws + W_RSTDX);
  float* RSQH = (float*)(ws + W_RSQH);
  float* RSQH2 = (float*)(ws + W_RSQH2);
  for (int r = bid * 8 + wid; r < MT; r += nb * 8) {
    const float* xr = r < MP ? P.x_p + (size_t)r * 2048 : P.x_s + (size_t)(r - MP) * 2048;
    const float* pr = r < MP ? P.p_p + (size_t)r * 256 : P.p_s + (size_t)(r - MP) * 256;
    float ss = 0.f;
    u16* xb = XB + (size_t)r * 2048;
#pragma unroll
    for (int it = 0; it < 8; ++it) {
      f32x4 v = ((const f32x4*)xr)[it * 64 + lane];
      ss += v[0] * v[0] + v[1] * v[1] + v[2] * v[2] + v[3] * v[3];
      u32x2 o;
      o[0] = pk_bf16(v[0], v[1]);
      o[1] = pk_bf16(v[2], v[3]);
      ((u32x2*)xb)[it * 64 + lane] = o;
    }
    ss = wave_sum(ss);
    {
      f32x4 v = ((const f32x4*)pr)[lane];
      u32x2 o;
      o[0] = pk_bf16(v[0], v[1]);
      o[1] = pk_bf16(v[2], v[3]);
      ((u32x2*)(PB + (size_t)r * 256))[lane] = o;
    }
    if (lane == 0) {
      RSTDX[r] = rsqrtf(ss * (1.f / 2048.f) + EPS);
      RSQH[r] = 0.f;
      RSQH2[r] = 0.f;
    }
  }
  {
    const int T_IN = 92 * 32, T_OUT = 32 * 32, T_G = 32 * 32, T_P = 32 * 4;
    const int TT = T_IN + T_OUT + T_G + T_P;
    for (int tl = bid; tl < TT; tl += nb) {
      if (tl < T_IN) {
        int nt_ = tl / 32, kt_ = tl % 32;
        transpose_tile(P.w_in, 5648, 2048, nt_ * 64, kt_ * 64, (u16*)(ws + W_WIN), P.g_mix, 1);
      } else if (tl < T_IN + T_OUT) {
        int q = tl - T_IN, nt_ = q / 32, kt_ = q % 32;
        transpose_tile(P.w_out, 2048, 2048, nt_ * 64, kt_ * 64, (u16*)(ws + W_WOUT), nullptr, 0);
      } else if (tl < T_IN + T_OUT + T_G) {
        int q = tl - T_IN - T_OUT, nt_ = q / 32, kt_ = q % 32;
        transpose_tile(P.w_pg, 2048, 2048, nt_ * 64, kt_ * 64, (u16*)(ws + W_WG), P.g_ple, 0);
      } else {
        int q = tl - T_IN - T_OUT - T_G, nt_ = q / 4, kt_ = q % 4;
        transpose_tile(P.w_pp, 2048, 256, nt_ * 64, kt_ * 64, (u16*)(ws + W_WP), nullptr, 0);
      }
    }
  }
  const int gtid = bid * 512 + tid, gsz = nb * 512;
  {
    u16* K2S = (u16*)(ws + W_K2S);
    u16* VT2S = (u16*)(ws + W_VT2S);
    for (int i = gtid; i < 8 * 128 * 4 * 64; i += gsz) {
      int sb = i >> 15, pos = (i >> 8) & 127, kvh = (i >> 6) & 3, d = i & 63;
      K2S[((size_t)(sb * 4 + kvh) * 160 + pos) * 64 + d] = f2bf(P.ck[i]);
      VT2S[((size_t)(sb * 4 + kvh) * 64 + d) * 160 + pos] = f2bf(P.cv[i]);
    }
  }
  {
    u32x4* z = (u32x4*)((u16*)(ws + W_VT1) + (size_t)2048 * 16384);
    for (int i = gtid; i < 32 * 16384 / 8; i += gsz) z[i] = u32x4{0u, 0u, 0u, 0u};
  }
  {
    u16* S = (u16*)(ws + W_S) + (size_t)2048 * 32768;
    for (int i = gtid; i < 32 * 4096; i += gsz) {
      int su = i >> 12, q = i & 4095;
      int ln = q & 63, ks = (q >> 6) & 7, ntl = q >> 9;
      int dv = ntl * 32 + (ln & 31), dk0 = ks * 16 + (ln >> 5) * 8;
      const float* src = P.state + (size_t)su * 32768 + (size_t)dk0 * 256 + dv;
      u32x4 o;
      o[0] = pk_bf16(src[0], src[256]);
      o[1] = pk_bf16(src[512], src[768]);
      o[2] = pk_bf16(src[1024], src[1280]);
      o[3] = pk_bf16(src[1536], src[1792]);
      ((u32x4*)(S + (size_t)su * 32768))[q] = o;
    }
  }
}

DI void store_bf4(u16* p, f32x4 v) {
  u32x2 o;
  o[0] = pk_bf16(v[0], v[1]);
  o[1] = pk_bf16(v[2], v[3]);
  *(u32x2*)p = o;
}

DI void phase_inproj() {
  const Params P = load_params();
  char* ws = P.ws;
  const u16* XB = (const u16*)(ws + W_XB);
  const u16* WIN = (const u16*)(ws + W_WIN);
  const float* RSTDX = (const float*)(ws + W_RSTDX);
  const int tid = get_tid();
  const int wid = __builtin_amdgcn_readfirstlane(tid >> 6), wr = wid >> 2, wc = wid & 3;
  f32x4 acc[2][2][4][2];
  int pm, pn;
  for (int it = 0; next_tile(it, 129, 23, pm, pn); ++it) {
    const int brow = pm * 256, bcol = pn * 256;
    gemm_kloop(XB, WIN, 2048, brow, bcol, acc, tid);
    int te = tid;
    asm volatile("" : "+v"(te));
    const int fr = te & 15, fq = (te >> 4) & 3;
    int kind = 0, ld = 512, coff = 0;
    u16* dst = (u16*)(ws + W_Q1);
    if (pn < 2) { coff = pn * 256; }
    else if (pn < 4) { dst = (u16*)(ws + W_K1); coff = (pn - 2) * 256; }
    else if (pn < 8) { kind = 1; }
    else if (pn < 12) { dst = (u16*)(ws + W_Z1); ld = 1024; coff = (pn - 8) * 256; }
    else if (pn < 16) { dst = (u16*)(ws + W_Q2); ld = 1024; coff = (pn - 12) * 256; }
    else if (pn == 16) { kind = 2; }
    else if (pn == 17) { kind = 3; }
    else if (pn < 22) { dst = (u16*)(ws + W_Z2); ld = 1024; coff = (pn - 18) * 256; }
    else { kind = 4; }
    const int cb = wc * 32 + fq * 4;
    if (kind == 0) {
#pragma unroll
      for (int ai = 0; ai < 2; ++ai)
#pragma unroll
        for (int m = 0; m < 4; ++m) {
          const int row = brow + ai * 128 + wr * 64 + m * 16 + fr;
          const float rs = RSTDX[row];
          u16* dp = dst + (size_t)row * ld + coff + cb;
#pragma unroll
          for (int bj = 0; bj < 2; ++bj)
#pragma unroll
            for (int n = 0; n < 2; ++n) store_bf4(dp + bj * 128 + n * 16, acc[ai][bj][m][n] * rs);
          __builtin_amdgcn_sched_barrier(0);
        }
    } else if (kind == 1) {
      const int h = pn - 4;
#pragma unroll
      for (int ai = 0; ai < 2; ++ai)
#pragma unroll
        for (int m = 0; m < 4; ++m) {
          const int row = brow + ai * 128 + wr * 64 + m * 16 + fr;
          const float rs = RSTDX[row];
          int unit, t;
          if (row < MP) { unit = ((row >> 14) * 4 + h) * 256 + ((row & 16383) >> 6); t = row & 63; }
          else { unit = 2048 + ((row - MP) >> 5) * 4 + h; t = (row - MP) & 31; }
          u16* dp = (u16*)(ws + W_VT1) + ((size_t)unit * 256 + cb) * 64 + t;
#pragma unroll
          for (int bj = 0; bj < 2; ++bj)
#pragma unroll
            for (int n = 0; n < 2; ++n) {
              f32x4 v = acc[ai][bj][m][n] * rs;
              u16* d = dp + (bj * 128 + n * 16) * 64;
              d[0] = f2bf(v[0]); d[64] = f2bf(v[1]); d[128] = f2bf(v[2]); d[192] = f2bf(v[3]);
            }
          __builtin_amdgcn_sched_barrier(0);
        }
    } else if (kind == 2 || kind == 3) {
#pragma unroll
      for (int ai = 0; ai < 2; ++ai)
#pragma unroll
        for (int m = 0; m < 4; ++m) {
          const int row = brow + ai * 128 + wr * 64 + m * 16 + fr;
          const float rs = RSTDX[row];
          const bool isP = row < MP;
          const int b = row >> 14, pos = row & 16383;
          const int sT = row - MP, sb = sT >> 5, st = sT & 31;
#pragma unroll
          for (int bj = 0; bj < 2; ++bj)
#pragma unroll
            for (int n = 0; n < 2; ++n) {
              f32x4 v = acc[ai][bj][m][n] * rs;
              const int col = bj * 128 + n * 16 + cb;
              const int kvh = col >> 6, d0 = col & 63;
              if (kind == 2) {
                if (isP) {
                  store_bf4((u16*)(ws + W_K2P) + ((size_t)(b * 4 + kvh) * 16384 + pos) * 64 + d0, v);
                  if (pos >= LSEQ - 128)
                    *(f32x4*)(P.out + O_KP + ((size_t)(b * 128 + pos - (LSEQ - 128)) * 4 + kvh) * 64 + d0) = v;
                } else {
                  store_bf4((u16*)(ws + W_K2S) + ((size_t)(sb * 4 + kvh) * 160 + 128 + st) * 64 + d0, v);
                  *(f32x4*)(P.out + O_KS + (size_t)sT * 256 + col) = v;
                }
              } else {
                if (isP) {
                  u16* d = (u16*)(ws + W_VT2P) + ((size_t)(b * 4 + kvh) * 64 + d0) * 16384 + pos;
                  d[0] = f2bf(v[0]); d[16384] = f2bf(v[1]); d[32768] = f2bf(v[2]); d[49152] = f2bf(v[3]);
                  if (pos >= LSEQ - 128)
                    *(f32x4*)(P.out + O_VP + ((size_t)(b * 128 + pos - (LSEQ - 128)) * 4 + kvh) * 64 + d0) = v;
                } else {
                  u16* d = (u16*)(ws + W_VT2S) + ((size_t)(sb * 4 + kvh) * 64 + d0) * 160 + 128 + st;
                  d[0] = f2bf(v[0]); d[160] = f2bf(v[1]); d[320] = f2bf(v[2]); d[480] = f2bf(v[3]);
                  *(f32x4*)(P.out + O_VS + (size_t)sT * 256 + col) = v;
                }
              }
            }
          __builtin_amdgcn_sched_barrier(0);
        }
    } else {
      if (wc == 0 && fq < 4) {
#pragma unroll
        for (int ai = 0; ai < 2; ++ai)
#pragma unroll
          for (int m = 0; m < 4; ++m) {
            const int row = brow + ai * 128 + wr * 64 + m * 16 + fr;
            const float rs = RSTDX[row];
            *(f32x4*)((float*)(ws + W_LR) + (size_t)row * 16 + fq * 4) = acc[ai][0][m][0] * rs;
          }
      }
    }
  }
}

DI void gla_p1_unit(const Params& P, int u) {
  char* ws = P.ws;
  const int tid = get_tid(), lane = tid & 63, wid = tid >> 6;
  float* lr_s = (float*)smem_raw;
  float* b_s = (float*)(smem_raw + 4096);
  float* seg_s = (float*)(smem_raw + 4096 + 32768);
  u16* kdT = (u16*)(smem_raw + 4096 + 32768 + 2048);
  int T0, NT, h;
  if (u < 2048) { int sh = u >> 8, c = u & 255; h = sh & 3; T0 = (sh >> 2) * 16384 + c * 64; NT = 64; }
  else { int su = u - 2048; h = su & 3; T0 = MP + (su >> 2) * 32; NT = 32; }
  const float* LR = (const float*)(ws + W_LR);
  if (tid < 256) {
    int t = tid >> 2;
    f32x4 v = f32x4{0.f, 0.f, 0.f, 0.f};
    if (t < NT) v = *(const f32x4*)(LR + (size_t)(T0 + t) * 16 + (tid & 3) * 4);
    *(f32x4*)(lr_s + tid * 4) = v;
  }
  __syncthreads();
  {
    const int col = tid & 127, tq = tid >> 7;
    float w[16];
#pragma unroll
    for (int r = 0; r < 16; ++r) w[r] = P.w_gu[r * 512 + h * 128 + col];
    const float bias = P.b_gate[h * 128 + col];
    float run = 0.f;
#pragma unroll 4
    for (int tt = 0; tt < 16; ++tt) {
      const int t = tq * 16 + tt;
      float x = bias;
#pragma unroll
      for (int r4 = 0; r4 < 4; ++r4) {
        f32x4 l4 = *(const f32x4*)(lr_s + t * 16 + r4 * 4);
        x += l4[0] * w[r4 * 4] + l4[1] * w[r4 * 4 + 1] + l4[2] * w[r4 * 4 + 2] + l4[3] * w[r4 * 4 + 3];
      }
      float g = (fminf(x, 0.f) - __logf(1.f + __expf(-fabsf(x)))) * (1.f / 16.f);
      if (t >= NT) g = 0.f;
      run += g;
      b_s[t * 128 + col] = run;
    }
    seg_s[tq * 128 + col] = run;
  }
  __syncthreads();
  {
    u16* Q1 = (u16*)(ws + W_Q1);
    u16* K1 = (u16*)(ws + W_K1);
    float* DEC = (float*)(ws + W_DEC);
#pragma unroll
    for (int i = 0; i < 2; ++i) {
      const int e = tid + i * 512, t = e >> 4, c8 = (e & 15) * 8, tq = t >> 4;
      float bb[8], bl[8];
#pragma unroll
      for (int j = 0; j < 8; ++j) {
        float s0 = seg_s[c8 + j], s1 = seg_s[128 + c8 + j], s2 = seg_s[256 + c8 + j], s3 = seg_s[384 + c8 + j];
        float pre = (tq > 0 ? s0 : 0.f) + (tq > 1 ? s1 : 0.f) + (tq > 2 ? s2 : 0.f);
        bb[j] = b_s[t * 128 + c8 + j] + pre;
        bl[j] = s0 + s1 + s2 + s3;
      }
      u32x4 qv = u32x4{0u, 0u, 0u, 0u}, kv = u32x4{0u, 0u, 0u, 0u};
      const size_t off = (size_t)(T0 + t) * 512 + h * 128 + c8;
      if (t < NT) { qv = *(const u32x4*)(Q1 + off); kv = *(const u32x4*)(K1 + off); }
      u32x4 qo, ko;
      float kd[8];
#pragma unroll
      for (int jj = 0; jj < 4; ++jj) {
        float q0 = bflo(qv[jj]), q1 = bfhi(qv[jj]), k0 = bflo(kv[jj]), k1 = bfhi(kv[jj]);
        float e0 = __expf(bb[2 * jj]), e1 = __expf(bb[2 * jj + 1]);
        float i0 = __expf(-bb[2 * jj]), i1 = __expf(-bb[2 * jj + 1]);
        qo[jj] = pk_bf16(q0 * e0, q1 * e1);
        ko[jj] = pk_bf16(k0 * i0, k1 * i1);
        kd[2 * jj] = k0 * __expf(bl[2 * jj] - bb[2 * jj]);
        kd[2 * jj + 1] = k1 * __expf(bl[2 * jj + 1] - bb[2 * jj + 1]);
      }
      if (t < NT) { *(u32x4*)(Q1 + off) = qo; *(u32x4*)(K1 + off) = ko; }
#pragma unroll
      for (int j = 0; j < 8; ++j) kdT[(c8 + j) * 72 + t] = f2bf(kd[j]);
      if (t == 0) {
#pragma unroll
        for (int j = 0; j < 8; ++j) DEC[(size_t)u * 128 + c8 + j] = __expf(bl[j]);
      }
    }
  }
  __syncthreads();
  {
    const int mt = wid & 3, ng = wid >> 2, l31 = lane & 31, hf = lane >> 5;
    bf16x8 a[4];
#pragma unroll
    for (int ks = 0; ks < 4; ++ks) a[ks] = *(const bf16x8*)(kdT + (mt * 32 + l31) * 72 + ks * 16 + hf * 8);
    const u16* VT1 = (const u16*)(ws + W_VT1) + (size_t)u * 16384;
    float* U = (float*)(ws + W_U) + (size_t)u * 32768;
#pragma unroll
    for (int q = 0; q < 4; ++q) {
      const int ntile = ng * 4 + q;
      f32x16 c;
#pragma unroll
      for (int i = 0; i < 16; ++i) c[i] = 0.f;
#pragma unroll
      for (int ks = 0; ks < 4; ++ks) {
        bf16x8 bfr = *(const bf16x8*)(VT1 + (ntile * 32 + l31) * 64 + ks * 16 + hf * 8);
        c = __builtin_amdgcn_mfma_f32_32x32x16_bf16(a[ks], bfr, c, 0, 0, 0);
      }
#pragma unroll
      for (int g = 0; g < 4; ++g) {
        f32x4 o = f32x4{c[4 * g], c[4 * g + 1], c[4 * g + 2], c[4 * g + 3]};
        *(f32x4*)(U + ((size_t)((ntile * 8 + mt * 2 + (g >> 1)) * 64 + (g & 1) * 32 + l31)) * 8 + 4 * hf) = o;
      }
    }
  }
  __syncthreads();
}

DI void swa_unit(const Params& P, const u16* __restrict__ kb, const u16* __restrict__ vb, const int vstride,
                 const int pos0, const int kt_start, const int nkt, const int T0, const int kvh, const int g,
                 const int tofs) {
  char* ws = P.ws;
  const int lane = get_tid() & 63, l31 = lane & 31, hf = lane >> 5;
  const u16* Q2 = (const u16*)(ws + W_Q2);
  const int hc = kvh * 256 + g * 64;
  const size_t qrow = (size_t)(T0 + tofs + l31);
  bf16x8 qf[4];
#pragma unroll
  for (int ks = 0; ks < 4; ++ks) qf[ks] = *(const bf16x8*)(Q2 + qrow * 1024 + hc + ks * 16 + hf * 8);
  f32x16 s[6];
#pragma unroll
  for (int kt = 0; kt < 6; ++kt) {
#pragma unroll
    for (int i = 0; i < 16; ++i) s[kt][i] = -1e30f;
    if (kt >= kt_start && kt < nkt) {
      f32x16 c;
#pragma unroll
      for (int i = 0; i < 16; ++i) c[i] = 0.f;
      const u16* kp = kb + (size_t)(pos0 + kt * 32 + l31) * 64 + hf * 8;
#pragma unroll
      for (int ks = 0; ks < 4; ++ks) {
        bf16x8 kf = *(const bf16x8*)(kp + ks * 16);
        c = __builtin_amdgcn_mfma_f32_32x32x16_bf16(kf, qf[ks], c, 0, 0, 0);
      }
      s[kt] = c;
    }
  }
  const float sink = P.sinks[kvh * 4 + g];
  float mx = sink;
#pragma unroll
  for (int kt = 0; kt < 6; ++kt)
#pragma unroll
    for (int i = 0; i < 16; ++i) mx = fmaxf(mx, s[kt][i]);
  mx = fmaxf(mx, __shfl_xor(mx, 32));
  float sum = 0.f;
#pragma unroll
  for (int kt = 0; kt < 6; ++kt)
#pragma unroll
    for (int i = 0; i < 16; ++i) {
      float p = __expf(s[kt][i] - mx);
      s[kt][i] = p;
      sum += p;
    }
  sum += __shfl_xor(sum, 32);
  sum += __expf(sink - mx);
  const float inv = 1.f / sum;
  f32x16 o[2];
#pragma unroll
  for (int nt2 = 0; nt2 < 2; ++nt2)
#pragma unroll
    for (int i = 0; i < 16; ++i) o[nt2][i] = 0.f;
#pragma unroll
  for (int kt = 0; kt < 6; ++kt) {
    if (kt >= kt_start && kt < nkt) {
#pragma unroll
      for (int sub = 0; sub < 2; ++sub) {
        union { bf16x8 v; unsigned w[4]; } pf;
#pragma unroll
        for (int jj = 0; jj < 4; ++jj)
          pf.w[jj] = pk_bf16(s[kt][sub * 8 + 2 * jj] * inv, s[kt][sub * 8 + 2 * jj + 1] * inv);
        const int key0 = pos0 + kt * 32 + sub * 16 + 4 * hf;
#pragma unroll
        for (int nt2 = 0; nt2 < 2; ++nt2) {
          const u16* vp = vb + (size_t)(nt2 * 32 + l31) * vstride + key0;
          union { bf16x8 v; u32x2 h2[2]; } vf;
          vf.h2[0] = *(const u32x2*)(vp);
          vf.h2[1] = *(const u32x2*)(vp + 8);
          o[nt2] = __builtin_amdgcn_mfma_f32_32x32x16_bf16(pf.v, vf.v, o[nt2], 0, 0, 0);
        }
      }
    }
  }
  const u16* Z2 = (const u16*)(ws + W_Z2);
  u16* MIX = (u16*)(ws + W_MIX);
#pragma unroll
  for (int nt2 = 0; nt2 < 2; ++nt2)
#pragma unroll
    for (int i = 0; i < 16; ++i) {
      const int t = (i & 3) + 8 * (i >> 2) + 4 * hf;
      const size_t row = (size_t)(T0 + tofs + t);
      const int col = hc + nt2 * 32 + l31;
      float z = bf2f(Z2[row * 1024 + col]);
      MIX[row * 2048 + 1024 + col] = f2bf(o[nt2][i] * siluf_(z));
    }
}

DI void phase_mix1() {
  const Params P = load_params();
  char* ws = P.ws;
  const int wid = get_tid() >> 6;
  const int total = NU + 2048 + 32;
  for (int item = blockIdx.x; item < total; item += gridDim.x) {
    if (item < NU) {
      gla_p1_unit(P, item);
    } else if (item < NU + 2048) {
      const int q = item - NU, kvh = q & 3, c = (q >> 2) & 255, b = q >> 10;
      const u16* kb = (const u16*)(ws + W_K2P) + (size_t)(b * 4 + kvh) * 16384 * 64;
      const u16* vb = (const u16*)(ws + W_VT2P) + (size_t)(b * 4 + kvh) * 64 * 16384;
      const int kt_start = c == 0 ? 4 : (c == 1 ? 2 : 0);
      swa_unit(P, kb, vb, 16384, c * 64 - 128, kt_start, 6, b * 16384 + c * 64, kvh, wid >> 1, (wid & 1) * 32);
    } else {
      const int q = item - NU - 2048, kvh = q & 3, sb = q >> 2;
      if (wid < 4) {
        const u16* kb = (const u16*)(ws + W_K2S) + (size_t)(sb * 4 + kvh) * 160 * 64;
        const u16* vb = (const u16*)(ws + W_VT2S) + (size_t)(sb * 4 + kvh) * 64 * 160;
        swa_unit(P, kb, vb, 160, 0, 0, 5, MP + sb * 32, kvh, wid, 0);
      }
    }
  }
}

DI void phase_scan() {
  const Params P = load_params();
  char* ws = P.ws;
  const float* U = (const float*)(ws + W_U);
  u16* S = (u16*)(ws + W_S);
  const float* DEC = (const float*)(ws + W_DEC);
  const int gtid = blockIdx.x * 512 + get_tid(), gsz = gridDim.x * 512;
  for (int item = gtid; item < 8 * 16384; item += gsz) {
    const int sh = item >> 14, q2 = item & 16383;
    const int j0 = (q2 & 3) * 2, ln = (q2 >> 2) & 63, ks = (q2 >> 8) & 7, ntl = q2 >> 11;
    const int dk = ks * 16 + (ln >> 5) * 8 + j0, dv = ntl * 32 + (ln & 31);
    float s0 = 0.f, s1 = 0.f;
    const size_t ubase = (size_t)sh * 256 * 32768 + (size_t)q2 * 2;
    const size_t dbase = (size_t)sh * 256 * 128 + dk;
    for (int c0 = 0; c0 < 256; c0 += 8) {
      float2 uu[8], dd[8];
#pragma unroll
      for (int i = 0; i < 8; ++i) {
        uu[i] = *(const float2*)(U + ubase + (size_t)(c0 + i) * 32768);
        dd[i] = *(const float2*)(DEC + dbase + (size_t)(c0 + i) * 128);
      }
#pragma unroll
      for (int i = 0; i < 8; ++i) {
        *(unsigned*)(S + ubase + (size_t)(c0 + i) * 32768) = pk_bf16(s0, s1);
        s0 = dd[i].x * s0 + uu[i].x;
        s1 = dd[i].y * s1 + uu[i].y;
      }
    }
    float* o = P.out + O_SGP + (size_t)sh * 32768 + (size_t)dk * 256 + dv;
    o[0] = s0;
    o[256] = s1;
  }
  for (int item = gtid; item < 32 * 16384; item += gsz) {
    const int su = item >> 14, q2 = item & 16383;
    const int j0 = (q2 & 3) * 2, ln = (q2 >> 2) & 63, ks = (q2 >> 8) & 7, ntl = q2 >> 11;
    const int dk = ks * 16 + (ln >> 5) * 8 + j0, dv = ntl * 32 + (ln & 31);
    const float2 uu = *(const float2*)(U + (size_t)(2048 + su) * 32768 + (size_t)q2 * 2);
    const float2 dd = *(const float2*)(DEC + (size_t)(2048 + su) * 128 + dk);
    const float* s0p = P.state + (size_t)su * 32768 + (size_t)dk * 256 + dv;
    float* o = P.out + O_SGS + (size_t)su * 32768 + (size_t)dk * 256 + dv;
    o[0] = dd.x * s0p[0] + uu.x;
    o[256] = dd.y * s0p[256] + uu.y;
  }
}

DI void gla_p3_unit(const Params& P, int u) {
  char* ws = P.ws;
  const int tid = get_tid(), lane = tid & 63, w = tid >> 6, l31 = lane & 31, hf = lane >> 5;
  int T0, NT, h;
  if (u < 2048) { int sh = u >> 8, c = u & 255; h = sh & 3; T0 = (sh >> 2) * 16384 + c * 64; NT = 64; }
  else { int su = u - 2048; h = su & 3; T0 = MP + (su >> 2) * 32; NT = 32; }
  const u16* Q1 = (const u16*)(ws + W_Q1);
  const u16* K1 = (const u16*)(ws + W_K1);
  const u16* VT1 = (const u16*)(ws + W_VT1) + (size_t)u * 16384;
  const u16* S = (const u16*)(ws + W_S) + (size_t)u * 32768;
  float* o_s = (float*)smem_raw;
  const bool hi_ok = NT > 32;
  bf16x8 qf[2][8];
#pragma unroll
  for (int ti = 0; ti < 2; ++ti)
#pragma unroll
    for (int ks = 0; ks < 8; ++ks) {
      bf16x8 z;
#pragma unroll
      for (int j = 0; j < 8; ++j) z[j] = 0;
      if (ti == 0 || hi_ok) z = *(const bf16x8*)(Q1 + (size_t)(T0 + ti * 32 + l31) * 512 + h * 128 + ks * 16 + hf * 8);
      qf[ti][ks] = z;
    }
  f32x16 at00, at01, at11;
#pragma unroll
  for (int i = 0; i < 16; ++i) { at00[i] = 0.f; at01[i] = 0.f; at11[i] = 0.f; }
#pragma unroll
  for (int ks = 0; ks < 8; ++ks) {
    bf16x8 kf = *(const bf16x8*)(K1 + (size_t)(T0 + l31) * 512 + h * 128 + ks * 16 + hf * 8);
    at00 = __builtin_amdgcn_mfma_f32_32x32x16_bf16(kf, qf[0][ks], at00, 0, 0, 0);
    at01 = __builtin_amdgcn_mfma_f32_32x32x16_bf16(kf, qf[1][ks], at01, 0, 0, 0);
  }
  if (hi_ok) {
#pragma unroll
    for (int ks = 0; ks < 8; ++ks) {
      bf16x8 kf = *(const bf16x8*)(K1 + (size_t)(T0 + 32 + l31) * 512 + h * 128 + ks * 16 + hf * 8);
      at11 = __builtin_amdgcn_mfma_f32_32x32x16_bf16(kf, qf[1][ks], at11, 0, 0, 0);
    }
  }
  union PF { bf16x8 v; unsigned wd[4]; };
  PF p00[2], p01[2], p11[2];
#pragma unroll
  for (int sub = 0; sub < 2; ++sub)
#pragma unroll
    for (int jj = 0; jj < 4; ++jj) {
      const int i0 = sub * 8 + 2 * jj, i1 = i0 + 1;
      const int s0 = (i0 & 3) + 8 * (i0 >> 2) + 4 * hf, s1 = (i1 & 3) + 8 * (i1 >> 2) + 4 * hf;
      p00[sub].wd[jj] = pk_bf16(s0 <= l31 ? at00[i0] : 0.f, s1 <= l31 ? at00[i1] : 0.f);
      p01[sub].wd[jj] = pk_bf16(at01[i0], at01[i1]);
      p11[sub].wd[jj] = pk_bf16(s0 <= l31 ? at11[i0] : 0.f, s1 <= l31 ? at11[i1] : 0.f);
    }
  f32x16 o0, o1;
#pragma unroll
  for (int i = 0; i < 16; ++i) { o0[i] = 0.f; o1[i] = 0.f; }
  {
    const u16* vp = VT1 + (size_t)(w * 32 + l31) * 64 + 4 * hf;
#pragma unroll
    for (int sub = 0; sub < 2; ++sub) {
      union { bf16x8 v; u32x2 h2[2]; } vf;
      vf.h2[0] = *(const u32x2*)(vp + sub * 16);
      vf.h2[1] = *(const u32x2*)(vp + sub * 16 + 8);
      o0 = __builtin_amdgcn_mfma_f32_32x32x16_bf16(p00[sub].v, vf.v, o0, 0, 0, 0);
      o1 = __builtin_amdgcn_mfma_f32_32x32x16_bf16(p01[sub].v, vf.v, o1, 0, 0, 0);
    }
#pragma unroll
    for (int sub = 0; sub < 2; ++sub) {
      union { bf16x8 v; u32x2 h2[2]; } vf;
      vf.h2[0] = *(const u32x2*)(vp + 32 + sub * 16);
      vf.h2[1] = *(const u32x2*)(vp + 32 + sub * 16 + 8);
      o1 = __builtin_amdgcn_mfma_f32_32x32x16_bf16(p11[sub].v, vf.v, o1, 0, 0, 0);
    }
  }
#pragma unroll
  for (int ks = 0; ks < 8; ++ks) {
    bf16x8 sf = *(const bf16x8*)(S + ((size_t)(w * 8 + ks) * 64 + lane) * 8);
    o0 = __builtin_amdgcn_mfma_f32_32x32x16_bf16(qf[0][ks], sf, o0, 0, 0, 0);
    o1 = __builtin_amdgcn_mfma_f32_32x32x16_bf16(qf[1][ks], sf, o1, 0, 0, 0);
  }
#pragma unroll
  for (int i = 0; i < 16; ++i) {
    const int t = (i & 3) + 8 * (i >> 2) + 4 * hf;
    o_s[t * 260 + w * 32 + l31] = o0[i];
    o_s[(32 + t) * 260 + w * 32 + l31] = o1[i];
  }
  __syncthreads();
  {
    const int row = tid >> 3, seg = tid & 7;
    f32x4 v[8];
    float ss = 0.f;
#pragma unroll
    for (int i = 0; i < 8; ++i) {
      v[i] = *(const f32x4*)(o_s + row * 260 + seg * 32 + i * 4);
      ss += v[i][0] * v[i][0] + v[i][1] * v[i][1] + v[i][2] * v[i][2] + v[i][3] * v[i][3];
    }
    ss += __shfl_xor(ss, 1);
    ss += __shfl_xor(ss, 2);
    ss += __shfl_xor(ss, 4);
    const float rstd = rsqrtf(ss * (1.f / 256.f) + EPS);
    if (row < NT) {
      const size_t trow = (size_t)(T0 + row);
      const u16* zp = (const u16*)(ws + W_Z1) + trow * 1024 + h * 256 + seg * 32;
      u16* mp = (u16*)(ws + W_MIX) + trow * 2048 + h * 256 + seg * 32;
      const float* gg = P.g_gla + seg * 32;
#pragma unroll
      for (int i2 = 0; i2 < 4; ++i2) {
        u32x4 zz = *(const u32x4*)(zp + i2 * 8);
        f32x4 g0 = *(const f32x4*)(gg + i2 * 8), g1 = *(const f32x4*)(gg + i2 * 8 + 4);
        f32x4 a = v[2 * i2], bq = v[2 * i2 + 1];
        u32x4 oo;
        oo[0] = pk_bf16(a[0] * rstd * g0[0] * siluf_(bflo(zz[0])), a[1] * rstd * g0[1] * siluf_(bfhi(zz[0])));
        oo[1] = pk_bf16(a[2] * rstd * g0[2] * siluf_(bflo(zz[1])), a[3] * rstd * g0[3] * siluf_(bfhi(zz[1])));
        oo[2] = pk_bf16(bq[0] * rstd * g1[0] * siluf_(bflo(zz[2])), bq[1] * rstd * g1[1] * siluf_(bfhi(zz[2])));
        oo[3] = pk_bf16(bq[2] * rstd * g1[2] * siluf_(bflo(zz[3])), bq[3] * rstd * g1[3] * siluf_(bfhi(zz[3])));
        *(u32x4*)(mp + i2 * 8) = oo;
      }
    }
  }
  __syncthreads();
}

DI void phase_p3() {
  const Params P = load_params();
  for (int u = blockIdx.x; u < NU; u += gridDim.x) gla_p3_unit(P, u);
}

DI void phase_outproj() {
  const Params P = load_params();
  char* ws = P.ws;
  const u16* MIX = (const u16*)(ws + W_MIX);
  const u16* WOUT = (const u16*)(ws + W_WOUT);
  u16* HB = (u16*)(ws + W_HB);
  float* RSQH = (float*)(ws + W_RSQH);
  const int tid = get_tid();
  const int wid = __builtin_amdgcn_readfirstlane(tid >> 6), wr = wid >> 2, wc = wid & 3;
  f32x4 acc[2][2][4][2];
  int pm, pn;
  for (int it = 0; next_tile(it, 129, 8, pm, pn); ++it) {
    const int brow = pm * 256, bcol = pn * 256;
    gemm_kloop(MIX, WOUT, 2048, brow, bcol, acc, tid);
    int te = tid;
    asm volatile("" : "+v"(te));
    const int fr = te & 15, fq = (te >> 4) & 3;
#pragma unroll
    for (int ai = 0; ai < 2; ++ai)
#pragma unroll
      for (int m = 0; m < 4; ++m) {
        const int row = brow + ai * 128 + wr * 64 + m * 16 + fr;
        const float* xr = row < MP ? P.x_p + (size_t)row * 2048 : P.x_s + (size_t)(row - MP) * 2048;
        float ss = 0.f;
#pragma unroll
        for (int bj = 0; bj < 2; ++bj)
#pragma unroll
          for (int n = 0; n < 2; ++n) {
            const int col = bcol + bj * 128 + wc * 32 + n * 16 + fq * 4;
            f32x4 hv = acc[ai][bj][m][n] + *(const f32x4*)(xr + col);
            ss += hv[0] * hv[0] + hv[1] * hv[1] + hv[2] * hv[2] + hv[3] * hv[3];
            store_bf4(HB + (size_t)row * 2048 + col, hv);
          }
        ss += __shfl_xor(ss, 16);
        ss += __shfl_xor(ss, 32);
        if (fq == 0) unsafeAtomicAdd(RSQH + row, ss);
        __builtin_amdgcn_sched_barrier(0);
      }
  }
}

DI void phase_ple() {
  const Params P = load_params();
  char* ws = P.ws;
  const u16* HB = (const u16*)(ws + W_HB);
  const u16* WG = (const u16*)(ws + W_WG);
  const u16* PB = (const u16*)(ws + W_PB);
  const u16* WP = (const u16*)(ws + W_WP);
  const float* RSQH = (const float*)(ws + W_RSQH);
  float* RSQH2 = (float*)(ws + W_RSQH2);
  u16* H2B = (u16*)(ws + W_H2B);
  u32x4* stash = (u32x4*)(ws + W_STASH + (size_t)blockIdx.x * 131072);
  const int tid = get_tid();
  const int wid = __builtin_amdgcn_readfirstlane(tid >> 6), wr = wid >> 2, wc = wid & 3;
  f32x4 acc[2][2][4][2];
  int pm, pn;
  for (int it = 0; next_tile(it, 129, 8, pm, pn); ++it) {
    const int brow = pm * 256, bcol = pn * 256;
    gemm_kloop(HB, WG, 2048, brow, bcol, acc, tid);
    int te = tid;
    asm volatile("" : "+v"(te));
    const int fr = te & 15, fq = (te >> 4) & 3;
#pragma unroll
    for (int ai = 0; ai < 2; ++ai)
#pragma unroll
      for (int m = 0; m < 4; ++m) {
        const int row = brow + ai * 128 + wr * 64 + m * 16 + fr;
        const float rs = rsqrtf(RSQH[row] * (1.f / 2048.f) + EPS);
#pragma unroll
        for (int bj = 0; bj < 2; ++bj) {
          f32x4 a = acc[ai][bj][m][0], bq = acc[ai][bj][m][1];
          u32x4 o;
          o[0] = pk_bf16(sigmoidf_(a[0] * rs), sigmoidf_(a[1] * rs));
          o[1] = pk_bf16(sigmoidf_(a[2] * rs), sigmoidf_(a[3] * rs));
          o[2] = pk_bf16(sigmoidf_(bq[0] * rs), sigmoidf_(bq[1] * rs));
          o[3] = pk_bf16(sigmoidf_(bq[2] * rs), sigmoidf_(bq[3] * rs));
          stash[(size_t)((ai * 4 + m) * 2 + bj) * 512 + te] = o;
        }
        __builtin_amdgcn_sched_barrier(0);
      }
    gemm_kloop(PB, WP, 256, brow, bcol, acc, tid);
    int te2 = tid;
    asm volatile("" : "+v"(te2));
    const int fr2 = te2 & 15, fq2 = (te2 >> 4) & 3;
#pragma unroll
    for (int ai = 0; ai < 2; ++ai)
#pragma unroll
      for (int m = 0; m < 4; ++m) {
        const int row = brow + ai * 128 + wr * 64 + m * 16 + fr2;
        float ss = 0.f;
#pragma unroll
        for (int bj = 0; bj < 2; ++bj) {
          u32x4 gt = stash[(size_t)((ai * 4 + m) * 2 + bj) * 512 + te2];
#pragma unroll
          for (int n = 0; n < 2; ++n) {
            const int col = bcol + bj * 128 + wc * 32 + n * 16 + fq2 * 4;
            const u32x2 hraw = *(const u32x2*)(HB + (size_t)row * 2048 + col);
            f32x4 hv = f32x4{bflo(hraw[0]), bfhi(hraw[0]), bflo(hraw[1]), bfhi(hraw[1])};
            f32x4 pp = acc[ai][bj][m][n];
            f32x4 gv = f32x4{bflo(gt[2 * n]), bfhi(gt[2 * n]), bflo(gt[2 * n + 1]), bfhi(gt[2 * n + 1])};
            f32x4 h2 = hv + gv * pp;
            ss += h2[0] * h2[0] + h2[1] * h2[1] + h2[2] * h2[2] + h2[3] * h2[3];
            store_bf4(H2B + (size_t)row * 2048 + col, h2);
          }
        }
        ss += __shfl_xor(ss, 16);
        ss += __shfl_xor(ss, 32);
        if (fq2 == 0) unsafeAtomicAdd(RSQH2 + row, ss);
        __builtin_amdgcn_sched_barrier(0);
      }
  }
}

DI void phase_final() {
  const Params P = load_params();
  const float* RSQH2 = (const float*)(P.ws + W_RSQH2);
  const u16* H2B = (const u16*)(P.ws + W_H2B);
  const size_t n8 = (size_t)MT * 256;
  for (size_t i = (size_t)blockIdx.x * 512 + get_tid(); i < n8; i += (size_t)gridDim.x * 512) {
    const int row = (int)(i >> 8), c8 = (int)(i & 255);
    const float rs = rsqrtf(RSQH2[row] * (1.f / 2048.f) + EPS);
    const u32x4 hv = ((const u32x4*)H2B)[i];
    const f32x4 g0 = ((const f32x4*)P.g_final)[c8 * 2], g1 = ((const f32x4*)P.g_final)[c8 * 2 + 1];
    f32x4 o0 = f32x4{bflo(hv[0]), bfhi(hv[0]), bflo(hv[1]), bfhi(hv[1])} * rs * g0;
    f32x4 o1 = f32x4{bflo(hv[2]), bfhi(hv[2]), bflo(hv[3]), bfhi(hv[3])} * rs * g1;
    f32x4* op = (f32x4*)(P.out + O_Y) + i * 2;
    op[0] = o0;
    op[1] = o1;
  }
}

__global__ void __launch_bounds__(512, 2) hymba_megakernel(Params Pk) {
  cg::grid_group grid = cg::this_grid();
  const int ph_lo = Pk.ph_lo, ph_hi = Pk.ph_hi;
#ifndef PROBE_MASK
#define PROBE_MASK 0
#endif
#define PROBE_MULT 2
#define RUN_PHASE(ph, call)                                   \
  if (ph_lo <= ph && ph < ph_hi) {                            \
    if (ph > ph_lo) grid.sync();                              \
    long long t0_ = 0;                                        \
    if (PROBE_MASK) t0_ = wall_clock64();                     \
    call;                                                     \
    if ((PROBE_MASK >> ph) & 1) {                             \
      if (ph == 7) __syncthreads();                           \
      probe_acc += wall_clock64() - t0_;                      \
    }                                                         \
  }
  long long probe_acc = 0;
  RUN_PHASE(0, phase_prep())
  RUN_PHASE(1, phase_inproj())
  RUN_PHASE(2, phase_mix1())
  RUN_PHASE(3, phase_scan())
  RUN_PHASE(4, phase_p3())
  RUN_PHASE(5, phase_outproj())
  RUN_PHASE(6, phase_ple())
  RUN_PHASE(7, phase_final())
  if (PROBE_MASK) {
    const long long tend = wall_clock64() + PROBE_MULT * probe_acc;
    while (wall_clock64() < tend) __builtin_amdgcn_s_sleep(8);
  }
}

extern "C" void kernel_launch(void* const* d_in, const int* in_sizes, int n_in, void* d_out, int out_size, void* d_ws,
                              size_t ws_size, hipStream_t stream) {
  static int grid_blocks = 0;
  if (!grid_blocks) {
    hipFuncSetAttribute((const void*)hymba_megakernel, hipFuncAttributeMaxDynamicSharedMemorySize, SHM_B);
    int dev = 0, cus = 0, per_cu = 0;
    hipGetDevice(&dev);
    hipDeviceGetAttribute(&cus, hipDeviceAttributeMultiprocessorCount, dev);
    hipOccupancyMaxActiveBlocksPerMultiprocessor(&per_cu, hymba_megakernel, 512, SHM_B);
    if (per_cu < 1) per_cu = 1;
    if (per_cu > 1) per_cu = 1;
    grid_blocks = cus * per_cu;
  }
  Params p{};
  p.x_p = (const float*)d_in[0]; p.x_s = (const float*)d_in[1]; p.p_p = (const float*)d_in[2];
  p.p_s = (const float*)d_in[3]; p.state = (const float*)d_in[4]; p.ck = (const float*)d_in[5];
  p.cv = (const float*)d_in[6]; p.g_mix = (const float*)d_in[7]; p.w_in = (const float*)d_in[8];
  p.w_gu = (const float*)d_in[9]; p.b_gate = (const float*)d_in[10]; p.g_gla = (const float*)d_in[11];
  p.sinks = (const float*)d_in[12]; p.w_out = (const float*)d_in[13]; p.g_ple = (const float*)d_in[14];
  p.w_pg = (const float*)d_in[15]; p.w_pp = (const float*)d_in[16]; p.g_final = (const float*)d_in[17];
  p.out = (float*)d_out;
  p.ws = (char*)d_ws;
  p.ph_lo = 0;
  p.ph_hi = 8;
  void* args[] = {&p};
  hipError_t e = hipLaunchCooperativeKernel((const void*)hymba_megakernel, dim3(grid_blocks), dim3(512), args, SHM_B, stream);
  if (e != hipSuccess) fprintf(stderr, "cooperative launch failed: %s (grid %d)\n", hipGetErrorString(e), grid_blocks);
}
```

```cpp
#include <hip/hip_runtime.h>
#include <hip/hip_cooperative_groups.h>
#include <cstdio>
namespace cg = cooperative_groups;

typedef unsigned short u16;
using bf16x8 = __attribute__((ext_vector_type(8))) short;
using f32x4 = __attribute__((ext_vector_type(4))) float;
using f32x16 = __attribute__((ext_vector_type(16))) float;
using u32x2 = __attribute__((ext_vector_type(2))) unsigned;
using u32x4 = __attribute__((ext_vector_type(4))) unsigned;

#define DI __device__ __forceinline__

constexpr int MP = 32768, MS = 256, MT = MP + MS;
constexpr int LSEQ = 16384, DM = 2048;
constexpr int NIN = 5888;
constexpr int NU = 2080;
constexpr float EPS = 1e-6f;

constexpr size_t O_Y = 0;
constexpr size_t O_SGP = (size_t)MT * 2048;
constexpr size_t O_KP = O_SGP + 262144;
constexpr size_t O_VP = O_KP + 65536;
constexpr size_t O_SGS = O_VP + 65536;
constexpr size_t O_KS = O_SGS + 1048576;
constexpr size_t O_VS = O_KS + 65536;

constexpr size_t al256(size_t x) { return (x + 255) & ~(size_t)255; }
constexpr size_t W_XB = 0;
constexpr size_t W_PB = W_XB + al256((size_t)MT * 2048 * 2);
constexpr size_t W_WIN = W_PB + al256((size_t)MT * 256 * 2);
constexpr size_t W_WOUT = W_WIN + al256((size_t)NIN * 2048 * 2);
constexpr size_t W_WG = W_WOUT + al256((size_t)2048 * 2048 * 2);
constexpr size_t W_WP = W_WG + al256((size_t)2048 * 2048 * 2);
constexpr size_t W_RSTDX = W_WP + al256((size_t)2048 * 256 * 2);
constexpr size_t W_Q1 = W_RSTDX + al256((size_t)MT * 4);
constexpr size_t W_K1 = W_Q1 + al256((size_t)MT * 512 * 2);
constexpr size_t W_VT1 = W_K1 + al256((size_t)MT * 512 * 2);
constexpr size_t W_Z1 = W_VT1 + al256((size_t)NU * 256 * 64 * 2);
constexpr size_t W_Q2 = W_Z1 + al256((size_t)MT * 1024 * 2);
constexpr size_t W_K2P = W_Q2 + al256((size_t)MT * 1024 * 2);
constexpr size_t W_K2S = W_K2P + al256((size_t)8 * 16384 * 64 * 2);
constexpr size_t W_VT2P = W_K2S + al256((size_t)32 * 160 * 64 * 2);
constexpr size_t W_VT2S = W_VT2P + al256((size_t)8 * 64 * 16384 * 2);
constexpr size_t W_Z2 = W_VT2S + al256((size_t)32 * 64 * 160 * 2);
constexpr size_t W_LR = W_Z2 + al256((size_t)MT * 1024 * 2);
constexpr size_t W_U = W_LR + al256((size_t)MT * 16 * 4);
constexpr size_t W_S = W_U + al256((size_t)NU * 32768 * 4);
constexpr size_t W_DEC = W_S + al256((size_t)NU * 32768 * 2);
constexpr size_t W_RSQH = W_DEC + al256((size_t)NU * 128 * 4);
constexpr size_t W_RSQH2 = W_RSQH + al256((size_t)MT * 4);
constexpr size_t W_CNT = W_RSQH2 + al256((size_t)MT * 4);
constexpr size_t W_END = W_CNT + 1024;
constexpr size_t W_MIX = W_XB;
constexpr size_t W_H2B = W_XB;
constexpr size_t W_HB = W_Q1;
constexpr size_t W_STASH = W_Z1;
static_assert(W_HB + (size_t)MT * 2048 * 2 <= W_Z1, "HB alias overflow");
static_assert(W_END <= (size_t)1073741824, "workspace too large");

struct Params {
  const float *x_p, *x_s, *p_p, *p_s, *state, *ck, *cv, *g_mix, *w_in, *w_gu, *b_gate, *g_gla, *sinks, *w_out,
      *g_ple, *w_pg, *w_pp, *g_final;
  float* out;
  char* ws;
  int ph_lo, ph_hi;
};

extern __shared__ __attribute__((aligned(16))) unsigned char smem_raw[];

typedef const __attribute__((address_space(4))) Params* KParamsPtr;
__device__ __forceinline__ Params load_params() {
  KParamsPtr kp = (KParamsPtr)__builtin_amdgcn_kernarg_segment_ptr();
  asm volatile("" : "+s"(kp));
  Params r;
  r.x_p = kp->x_p; r.x_s = kp->x_s; r.p_p = kp->p_p; r.p_s = kp->p_s; r.state = kp->state; r.ck = kp->ck; r.cv = kp->cv;
  r.g_mix = kp->g_mix; r.w_in = kp->w_in; r.w_gu = kp->w_gu; r.b_gate = kp->b_gate; r.g_gla = kp->g_gla;
  r.sinks = kp->sinks; r.w_out = kp->w_out; r.g_ple = kp->g_ple; r.w_pg = kp->w_pg; r.w_pp = kp->w_pp;
  r.g_final = kp->g_final; r.out = kp->out; r.ws = kp->ws; r.ph_lo = kp->ph_lo; r.ph_hi = kp->ph_hi;
  return r;
}

DI unsigned pk_bf16(float a, float b) {
  unsigned r;
  asm("v_cvt_pk_bf16_f32 %0, %1, %2" : "=v"(r) : "v"(a), "v"(b));
  return r;
}
DI u16 f2bf(float a) { return (u16)(pk_bf16(a, 0.f) & 0xffffu); }
DI float bf2f(u16 v) { return __uint_as_float(((unsigned)v) << 16); }
DI float bflo(unsigned v) { return __uint_as_float(v << 16); }
DI float bfhi(unsigned v) { return __uint_as_float(v & 0xffff0000u); }
DI float sigmoidf_(float x) { return 1.f / (1.f + __expf(-x)); }
DI float siluf_(float x) { return x / (1.f + __expf(-x)); }
DI int get_tid() {
  int t = threadIdx.x;
  asm volatile("" : "+v"(t));
  return t;
}
DI float wave_sum(float v) {
#pragma unroll
  for (int o = 32; o >= 1; o >>= 1) v += __shfl_xor(v, o);
  return v;
}

constexpr int BM = 256, BK = 64, HALF = 128, HT = HALF * BK;
constexpr int SHM_B = 8 * HT * 2;

DI int lds_byte(int r, int c) {
  int st = (r >> 4) * 2 + (c >> 5), rr = r & 15, cc = c & 31, ob = rr * 64 + cc * 2;
  return st * 1024 + (ob ^ (((ob >> 9) & 1) << 5));
}
DI void stage_rc(int b, int& R, int& C) {
  int st = b / 1024, sb = b % 1024, swz = sb ^ (((sb >> 9) & 1) << 5);
  R = (st >> 1) * 16 + swz / 64;
  C = (st & 1) * 32 + (swz % 64) / 2;
}

DI void gemm_kloop(const u16* __restrict__ A, const u16* __restrict__ Bt, const int K, const int brow, const int bcol,
                   f32x4 (&acc)[2][2][4][2], const int tid_) {
  u16* shm = (u16*)smem_raw;
#define SA(b, h) (shm + ((b)*2 + (h)) * HT)
#define SB(b, h) (shm + (4 + (b)*2 + (h)) * HT)
#define STAGE(P, BASE, br, kt)                                                                       \
  do {                                                                                               \
    const char* _gb = (const char*)(BASE + ((size_t)(br)*K + (size_t)(kt)*BK));                      \
    asm volatile("" : "+s"(_gb));                                                                    \
    __builtin_amdgcn_global_load_lds((const unsigned*)(_gb + (size_t)so0),                           \
                                     (__attribute__((address_space(3))) unsigned*)((char*)(P) + lw), 16, 0, 0); \
    __builtin_amdgcn_global_load_lds((const unsigned*)(_gb + (size_t)so1),                           \
                                     (__attribute__((address_space(3))) unsigned*)((char*)(P) + lw + 8192), 16, 0, 0); \
  } while (0)
#define LDA(dst, b, h)                                                                               \
  for (int m = 0; m < 4; ++m)                                                                        \
    for (int k = 0; k < 2; ++k)                                                                      \
  dst[m][k] = *reinterpret_cast<const bf16x8*>((char*)SA(b, h) + lds_byte(wr * 64 + m * 16 + fr, k * 32 + fq * 8))
#define LDB(dst, b, h)                                                                               \
  for (int n = 0; n < 2; ++n)                                                                        \
    for (int k = 0; k < 2; ++k)                                                                      \
  dst[n][k] = *reinterpret_cast<const bf16x8*>((char*)SB(b, h) + lds_byte(wc * 32 + n * 16 + fr, k * 32 + fq * 8))
#define MMA(ai, bj, At_, Bt_)                                                                        \
  do {                                                                                               \
    __builtin_amdgcn_s_setprio(1);                                                                   \
    for (int m = 0; m < 4; ++m)                                                                      \
      for (int n = 0; n < 2; ++n)                                                                    \
        for (int k = 0; k < 2; ++k)                                                                  \
          acc[ai][bj][m][n] = __builtin_amdgcn_mfma_f32_16x16x32_bf16(Bt_[n][k], At_[m][k], acc[ai][bj][m][n], 0, 0, 0); \
    __builtin_amdgcn_s_setprio(0);                                                                   \
  } while (0)
#define WAIT_V(n) asm volatile("s_waitcnt vmcnt(" #n ")" ::: "memory")
#define WAIT_L(n) asm volatile("s_waitcnt lgkmcnt(" #n ")" ::: "memory")
#define BAR __builtin_amdgcn_s_barrier()
#define SCHED __builtin_amdgcn_sched_barrier(0)

  const int wid = __builtin_amdgcn_readfirstlane(tid_ >> 6), lane = tid_ & 63, wr = wid >> 2, wc = wid & 3, fr = lane & 15, fq = lane >> 4;
  const int sb0 = tid_ * 16;
  unsigned so0, so1;
  {
    int r_, c_;
    stage_rc(sb0, r_, c_);
    so0 = (unsigned)(r_ * K + c_) * 2u;
    stage_rc(sb0 + 8192, r_, c_);
    so1 = (unsigned)(r_ * K + c_) * 2u;
  }
  const int lw = wid * 1024;
#pragma unroll
  for (int a = 0; a < 2; ++a)
#pragma unroll
    for (int b = 0; b < 2; ++b)
#pragma unroll
      for (int m = 0; m < 4; ++m)
#pragma unroll
        for (int n = 0; n < 2; ++n) acc[a][b][m][n] = f32x4{0.f, 0.f, 0.f, 0.f};
  bf16x8 At[4][2], B0[2][2], B1[2][2];
  const int nt = K / BK;
  STAGE(SB(0, 0), Bt, bcol, 0);
  STAGE(SA(0, 0), A, brow, 0);
  STAGE(SB(0, 1), Bt, bcol + HALF, 0);
  STAGE(SA(0, 1), A, brow + HALF, 0);
  if (wr == 1) BAR;
  WAIT_V(4);
  BAR;
  STAGE(SB(1, 0), Bt, bcol, 1);
  STAGE(SA(1, 0), A, brow, 1);
  STAGE(SB(1, 1), Bt, bcol + HALF, 1);
  WAIT_V(6);
  BAR;
  for (int t = 0; t < nt - 2; t += 2) {
    LDB(B0, 0, 0); SCHED; LDA(At, 0, 0); STAGE(SA(1, 1), A, brow + HALF, t + 1);
    WAIT_L(8); BAR; WAIT_L(0); MMA(0, 0, At, B0); BAR; SCHED;
    LDB(B1, 0, 1); STAGE(SB(0, 0), Bt, bcol, t + 2);
    BAR; WAIT_L(0); MMA(0, 1, At, B1); BAR;
    LDA(At, 0, 1); STAGE(SA(0, 0), A, brow, t + 2);
    BAR; WAIT_L(0); MMA(1, 0, At, B0); BAR; SCHED;
    STAGE(SB(0, 1), Bt, bcol + HALF, t + 2);
    WAIT_V(6); BAR; MMA(1, 1, At, B1); BAR;
    LDB(B0, 1, 0); SCHED; LDA(At, 1, 0); STAGE(SA(0, 1), A, brow + HALF, t + 2);
    WAIT_L(8); BAR; WAIT_L(0); MMA(0, 0, At, B0); BAR; SCHED;
    LDB(B1, 1, 1); STAGE(SB(1, 0), Bt, bcol, t + 3);
    BAR; WAIT_L(0); MMA(0, 1, At, B1); BAR;
    LDA(At, 1, 1); STAGE(SA(1, 0), A, brow, t + 3);
    BAR; WAIT_L(0); MMA(1, 0, At, B0); BAR; SCHED;
    STAGE(SB(1, 1), Bt, bcol + HALF, t + 3);
    WAIT_V(6); BAR; MMA(1, 1, At, B1); BAR;
  }
  {
    LDB(B0, 0, 0); LDA(At, 0, 0); STAGE(SA(1, 1), A, brow + HALF, nt - 1);
    BAR; WAIT_L(0); MMA(0, 0, At, B0); BAR;
    LDB(B1, 0, 1); BAR; WAIT_L(0); MMA(0, 1, At, B1); BAR;
    LDA(At, 0, 1); WAIT_V(4); BAR; WAIT_L(0); MMA(1, 0, At, B0); MMA(1, 1, At, B1); BAR;
  }
  {
    LDB(B0, 1, 0); LDA(At, 1, 0); WAIT_V(2); BAR; WAIT_L(0); MMA(0, 0, At, B0); BAR;
    LDB(B1, 1, 1); WAIT_V(0); BAR; WAIT_L(0); MMA(0, 1, At, B1); BAR;
    LDA(At, 1, 1); BAR; WAIT_L(0); MMA(1, 0, At, B0); MMA(1, 1, At, B1); BAR;
  }
  if (wr == 0) BAR;
#undef SA
#undef SB
#undef STAGE
#undef LDA
#undef LDB
#undef MMA
}

DI bool next_tile(int it, int nM, int nN, int& pm, int& pn, int rot = 0) {
  const int nb = gridDim.x;
  int bid = blockIdx.x + rot;
  if (bid >= nb) bid -= nb;
  int tl;
  if ((nb & 7) == 0) {
    int nloc = nb >> 3;
    tl = (it * 8 + (bid & 7)) * nloc + (bid >> 3);
  } else {
    tl = it * nb + bid;
  }
  if (tl >= nM * nN) return false;
  int nig = 8 * nN, g = tl / nig, rem = tl - g * nig, gsz = min(8, nM - g * 8);
  pm = g * 8 + rem % gsz;
  pn = rem / gsz;
  return true;
}

DI void transpose_task(const float* __restrict__ src, int ldsrc, int K, int n0, int k0, u16* __restrict__ dst,
                       const float* __restrict__ gvec, int mode, int lane) {
  const int np = n0 + lane;
  int scol = np;
  float cs = 1.f;
  bool valid = true;
  if (mode == 1) {
    if (np < 3072) scol = np;
    else if (np < 5632) scol = np + 16;
    else if (np < 5648) scol = 3072 + (np - 5632);
    else { valid = false; scol = 0; }
    if (np < 512) cs = 0.08838834764831845f;
    else if (np >= 3072 && np < 4096) cs = 0.125f;
  }
  if (!valid) cs = 0.f;
  const float* sp = src + (size_t)k0 * ldsrc + scol;
  u16* dp = dst + (size_t)np * K + k0;
#pragma unroll 2
  for (int k8 = 0; k8 < 16; ++k8) {
    float v[8];
#pragma unroll
    for (int j = 0; j < 8; ++j) v[j] = sp[(size_t)(k8 * 8 + j) * ldsrc];
    if (gvec) {
#pragma unroll
      for (int j = 0; j < 8; ++j) v[j] *= gvec[k0 + k8 * 8 + j];
    }
    u32x4 o;
    o[0] = pk_bf16(v[0] * cs, v[1] * cs);
    o[1] = pk_bf16(v[2] * cs, v[3] * cs);
    o[2] = pk_bf16(v[4] * cs, v[5] * cs);
    o[3] = pk_bf16(v[6] * cs, v[7] * cs);
    *(u32x4*)(dp + k8 * 8) = o;
  }
}

DI void phase_prep() {
  const Params P = load_params();
  const int tid = get_tid(), lane = tid & 63, wid = tid >> 6, nb = gridDim.x, bid = blockIdx.x;
  char* ws = P.ws;
  u16* XB = (u16*)(ws + W_XB);
  u16* PB = (u16*)(ws + W_PB);
  float* RSTDX = (float*)(ws + W_RSTDX);
  float* RSQH = (float*)(ws + W_RSQH);
  float* RSQH2 = (float*)(ws + W_RSQH2);
  for (int g = bid * 8 + wid; g < MT / 4; g += nb * 8) {
    const int r0 = g * 4;
    const float* xr = r0 < MP ? P.x_p + (size_t)r0 * 2048 : P.x_s + (size_t)(r0 - MP) * 2048;
    const float* pr = r0 < MP ? P.p_p + (size_t)r0 * 256 : P.p_s + (size_t)(r0 - MP) * 256;
    f32x4 v[4][8], pv[4];
#pragma unroll
    for (int j = 0; j < 4; ++j) {
#pragma unroll
      for (int it = 0; it < 8; ++it) v[j][it] = __builtin_nontemporal_load((const f32x4*)(xr + (size_t)j * 2048) + it * 64 + lane);
      pv[j] = __builtin_nontemporal_load((const f32x4*)(pr + (size_t)j * 256) + lane);
    }
#pragma unroll
    for (int j = 0; j < 4; ++j) {
      const int r = r0 + j;
      float ss = 0.f;
      u16* xb = XB + (size_t)r * 2048;
#pragma unroll
      for (int it = 0; it < 8; ++it) {
        f32x4 w = v[j][it];
        ss += w[0] * w[0] + w[1] * w[1] + w[2] * w[2] + w[3] * w[3];
        u32x2 o;
        o[0] = pk_bf16(w[0], w[1]);
        o[1] = pk_bf16(w[2], w[3]);
        ((u32x2*)xb)[it * 64 + lane] = o;
      }
      ss = wave_sum(ss);
      {
        u32x2 o;
        o[0] = pk_bf16(pv[j][0], pv[j][1]);
        o[1] = pk_bf16(pv[j][2], pv[j][3]);
        ((u32x2*)(PB + (size_t)r * 256))[lane] = o;
      }
      if (lane == 0) {
        RSTDX[r] = rsqrtf(ss * (1.f / 2048.f) + EPS);
        RSQH[r] = 0.f;
        RSQH2[r] = 0.f;
      }
    }
  }
  if (bid == 0 && tid < 256) ((int*)(ws + W_CNT))[tid] = 0;
  {
    const int T_IN = 92 * 16, T_OUT = 32 * 16, T_G = 32 * 16, T_P = 32 * 2;
    const int TT = T_IN + T_OUT + T_G + T_P;
    for (int tl = bid * 8 + wid; tl < TT; tl += nb * 8) {
      if (tl < T_IN) {
        int nt_ = tl / 16, kt_ = tl % 16;
        transpose_task(P.w_in, 5648, 2048, nt_ * 64, kt_ * 128, (u16*)(ws + W_WIN), P.g_mix, 1, lane);
      } else if (tl < T_IN + T_OUT) {
        int q = tl - T_IN, nt_ = q / 16, kt_ = q % 16;
        transpose_task(P.w_out, 2048, 2048, nt_ * 64, kt_ * 128, (u16*)(ws + W_WOUT), nullptr, 0, lane);
      } else if (tl < T_IN + T_OUT + T_G) {
        int q = tl - T_IN - T_OUT, nt_ = q / 16, kt_ = q % 16;
        transpose_task(P.w_pg, 2048, 2048, nt_ * 64, kt_ * 128, (u16*)(ws + W_WG), P.g_ple, 0, lane);
      } else {
        int q = tl - T_IN - T_OUT - T_G, nt_ = q / 2, kt_ = q % 2;
        transpose_task(P.w_pp, 2048, 256, nt_ * 64, kt_ * 128, (u16*)(ws + W_WP), nullptr, 0, lane);
      }
    }
  }
  const int gtid = bid * 512 + tid, gsz = nb * 512;
  {
    u16* K2S = (u16*)(ws + W_K2S);
    u16* VT2S = (u16*)(ws + W_VT2S);
    for (int i = gtid; i < 8 * 128 * 4 * 64; i += gsz) {
      int sb = i >> 15, pos = (i >> 8) & 127, kvh = (i >> 6) & 3, d = i & 63;
      K2S[((size_t)(sb * 4 + kvh) * 160 + pos) * 64 + d] = f2bf(P.ck[i]);
      VT2S[((size_t)(sb * 4 + kvh) * 64 + d) * 160 + pos] = f2bf(P.cv[i]);
    }
  }
  {
    u32x4* z = (u32x4*)((u16*)(ws + W_VT1) + (size_t)2048 * 16384);
    for (int i = gtid; i < 32 * 16384 / 8; i += gsz) z[i] = u32x4{0u, 0u, 0u, 0u};
  }
  {
    u16* S = (u16*)(ws + W_S) + (size_t)2048 * 32768;
    for (int i = gtid; i < 32 * 4096; i += gsz) {
      int su = i >> 12, q = i & 4095;
      int ln = q & 63, ks = (q >> 6) & 7, ntl = q >> 9;
      int dv = ntl * 32 + (ln & 31), dk0 = ks * 16 + (ln >> 5) * 8;
      const float* src = P.state + (size_t)su * 32768 + (size_t)dk0 * 256 + dv;
      u32x4 o;
      o[0] = pk_bf16(src[0], src[256]);
      o[1] = pk_bf16(src[512], src[768]);
      o[2] = pk_bf16(src[1024], src[1280]);
      o[3] = pk_bf16(src[1536], src[1792]);
      ((u32x4*)(S + (size_t)su * 32768))[q] = o;
    }
  }
}

DI void store_bf4(u16* p, f32x4 v) {
  u32x2 o;
  o[0] = pk_bf16(v[0], v[1]);
  o[1] = pk_bf16(v[2], v[3]);
  *(u32x2*)p = o;
}

DI void phase_inproj() {
  const Params P = load_params();
  char* ws = P.ws;
  const u16* XB = (const u16*)(ws + W_XB);
  const u16* WIN = (const u16*)(ws + W_WIN);
  const float* RSTDX = (const float*)(ws + W_RSTDX);
  const int tid = get_tid();
  const int wid = __builtin_amdgcn_readfirstlane(tid >> 6), wr = wid >> 2, wc = wid & 3;
  f32x4 acc[2][2][4][2];
  int pm, pn;
  for (int it = 0; next_tile(it, 129, 23, pm, pn); ++it) {
    const int brow = pm * 256, bcol = pn * 256;
    gemm_kloop(XB, WIN, 2048, brow, bcol, acc, tid);
    int te = tid;
    asm volatile("" : "+v"(te));
    const int fr = te & 15, fq = (te >> 4) & 3;
    int kind = 0, ld = 512, coff = 0;
    u16* dst = (u16*)(ws + W_Q1);
    if (pn < 2) { coff = pn * 256; }
    else if (pn < 4) { dst = (u16*)(ws + W_K1); coff = (pn - 2) * 256; }
    else if (pn < 8) { kind = 1; }
    else if (pn < 12) { dst = (u16*)(ws + W_Z1); ld = 1024; coff = (pn - 8) * 256; }
    else if (pn < 16) { dst = (u16*)(ws + W_Q2); ld = 1024; coff = (pn - 12) * 256; }
    else if (pn == 16) { kind = 2; }
    else if (pn == 17) { kind = 3; }
    else if (pn < 22) { dst = (u16*)(ws + W_Z2); ld = 1024; coff = (pn - 18) * 256; }
    else { kind = 4; }
    const int cb = wc * 32 + fq * 4;
    if (kind == 0) {
#pragma unroll
      for (int ai = 0; ai < 2; ++ai)
#pragma unroll
        for (int m = 0; m < 4; ++m) {
          const int row = brow + ai * 128 + wr * 64 + m * 16 + fr;
          const float rs = RSTDX[row];
          u16* dp = dst + (size_t)row * ld + coff + cb;
#pragma unroll
          for (int bj = 0; bj < 2; ++bj)
#pragma unroll
            for (int n = 0; n < 2; ++n) store_bf4(dp + bj * 128 + n * 16, acc[ai][bj][m][n] * rs);
          __builtin_amdgcn_sched_barrier(0);
        }
    } else if (kind == 1) {
      const int h = pn - 4;
#pragma unroll
      for (int ai = 0; ai < 2; ++ai)
#pragma unroll
        for (int m = 0; m < 4; ++m) {
          const int row = brow + ai * 128 + wr * 64 + m * 16 + fr;
          const float rs = RSTDX[row];
          int unit, t;
          if (row < MP) { unit = ((row >> 14) * 4 + h) * 256 + ((row & 16383) >> 6); t = row & 63; }
          else { unit = 2048 + ((row - MP) >> 5) * 4 + h; t = (row - MP) & 31; }
          u16* dp = (u16*)(ws + W_VT1) + ((size_t)unit * 256 + cb) * 64 + t;
#pragma unroll
          for (int bj = 0; bj < 2; ++bj)
#pragma unroll
            for (int n = 0; n < 2; ++n) {
              f32x4 v = acc[ai][bj][m][n] * rs;
              u16* d = dp + (bj * 128 + n * 16) * 64;
              d[0] = f2bf(v[0]); d[64] = f2bf(v[1]); d[128] = f2bf(v[2]); d[192] = f2bf(v[3]);
            }
          __builtin_amdgcn_sched_barrier(0);
        }
    } else if (kind == 2 || kind == 3) {
#pragma unroll
      for (int ai = 0; ai < 2; ++ai)
#pragma unroll
        for (int m = 0; m < 4; ++m) {
          const int row = brow + ai * 128 + wr * 64 + m * 16 + fr;
          const float rs = RSTDX[row];
          const bool isP = row < MP;
          const int b = row >> 14, pos = row & 16383;
          const int sT = row - MP, sb = sT >> 5, st = sT & 31;
#pragma unroll
          for (int bj = 0; bj < 2; ++bj)
#pragma unroll
            for (int n = 0; n < 2; ++n) {
              f32x4 v = acc[ai][bj][m][n] * rs;
              const int col = bj * 128 + n * 16 + cb;
              const int kvh = col >> 6, d0 = col & 63;
              if (kind == 2) {
                if (isP) {
                  store_bf4((u16*)(ws + W_K2P) + ((size_t)(b * 4 + kvh) * 16384 + pos) * 64 + d0, v);
                  if (pos >= LSEQ - 128)
                    *(f32x4*)(P.out + O_KP + ((size_t)(b * 128 + pos - (LSEQ - 128)) * 4 + kvh) * 64 + d0) = v;
                } else {
                  store_bf4((u16*)(ws + W_K2S) + ((size_t)(sb * 4 + kvh) * 160 + 128 + st) * 64 + d0, v);
                  *(f32x4*)(P.out + O_KS + (size_t)sT * 256 + col) = v;
                }
              } else {
                if (isP) {
                  u16* d = (u16*)(ws + W_VT2P) + ((size_t)(b * 4 + kvh) * 64 + d0) * 16384 + pos;
                  d[0] = f2bf(v[0]); d[16384] = f2bf(v[1]); d[32768] = f2bf(v[2]); d[49152] = f2bf(v[3]);
                  if (pos >= LSEQ - 128)
                    *(f32x4*)(P.out + O_VP + ((size_t)(b * 128 + pos - (LSEQ - 128)) * 4 + kvh) * 64 + d0) = v;
                } else {
                  u16* d = (u16*)(ws + W_VT2S) + ((size_t)(sb * 4 + kvh) * 64 + d0) * 160 + 128 + st;
                  d[0] = f2bf(v[0]); d[160] = f2bf(v[1]); d[320] = f2bf(v[2]); d[480] = f2bf(v[3]);
                  *(f32x4*)(P.out + O_VS + (size_t)sT * 256 + col) = v;
                }
              }
            }
          __builtin_amdgcn_sched_barrier(0);
        }
    } else {
      if (wc == 0 && fq < 4) {
#pragma unroll
        for (int ai = 0; ai < 2; ++ai)
#pragma unroll
          for (int m = 0; m < 4; ++m) {
            const int row = brow + ai * 128 + wr * 64 + m * 16 + fr;
            const float rs = RSTDX[row];
            *(f32x4*)((float*)(ws + W_LR) + (size_t)row * 16 + fq * 4) = acc[ai][0][m][0] * rs;
          }
      }
    }
  }
}

DI void gla_p1_unit(const Params& P, int u) {
  char* ws = P.ws;
  const int tid = get_tid(), lane = tid & 63, wid = tid >> 6;
  float* lr_s = (float*)smem_raw;
  float* b_s = (float*)(smem_raw + 4096);
  float* seg_s = (float*)(smem_raw + 4096 + 32768);
  u16* kdT = (u16*)(smem_raw + 4096 + 32768 + 2048);
  int T0, NT, h;
  if (u < 2048) { int sh = u >> 8, c = u & 255; h = sh & 3; T0 = (sh >> 2) * 16384 + c * 64; NT = 64; }
  else { int su = u - 2048; h = su & 3; T0 = MP + (su >> 2) * 32; NT = 32; }
  const float* LR = (const float*)(ws + W_LR);
  if (tid < 256) {
    int t = tid >> 2;
    f32x4 v = f32x4{0.f, 0.f, 0.f, 0.f};
    if (t < NT) v = *(const f32x4*)(LR + (size_t)(T0 + t) * 16 + (tid & 3) * 4);
    *(f32x4*)(lr_s + tid * 4) = v;
  }
  __syncthreads();
  {
    const int col = tid & 127, tq = tid >> 7;
    float w[16];
#pragma unroll
    for (int r = 0; r < 16; ++r) w[r] = P.w_gu[r * 512 + h * 128 + col];
    const float bias = P.b_gate[h * 128 + col];
    float run = 0.f;
#pragma unroll 4
    for (int tt = 0; tt < 16; ++tt) {
      const int t = tq * 16 + tt;
      float x = bias;
#pragma unroll
      for (int r4 = 0; r4 < 4; ++r4) {
        f32x4 l4 = *(const f32x4*)(lr_s + t * 16 + r4 * 4);
        x += l4[0] * w[r4 * 4] + l4[1] * w[r4 * 4 + 1] + l4[2] * w[r4 * 4 + 2] + l4[3] * w[r4 * 4 + 3];
      }
      float g = (fminf(x, 0.f) - __logf(1.f + __expf(-fabsf(x)))) * (1.f / 16.f);
      if (t >= NT) g = 0.f;
      run += g;
      b_s[t * 128 + col] = run;
    }
    seg_s[tq * 128 + col] = run;
  }
  __syncthreads();
  {
    u16* Q1 = (u16*)(ws + W_Q1);
    u16* K1 = (u16*)(ws + W_K1);
    float* DEC = (float*)(ws + W_DEC);
#pragma unroll
    for (int i = 0; i < 2; ++i) {
      const int e = tid + i * 512, t = e >> 4, c8 = (e & 15) * 8, tq = t >> 4;
      float bb[8], bl[8];
#pragma unroll
      for (int j = 0; j < 8; ++j) {
        float s0 = seg_s[c8 + j], s1 = seg_s[128 + c8 + j], s2 = seg_s[256 + c8 + j], s3 = seg_s[384 + c8 + j];
        float pre = (tq > 0 ? s0 : 0.f) + (tq > 1 ? s1 : 0.f) + (tq > 2 ? s2 : 0.f);
        bb[j] = b_s[t * 128 + c8 + j] + pre;
        bl[j] = s0 + s1 + s2 + s3;
      }
      u32x4 qv = u32x4{0u, 0u, 0u, 0u}, kv = u32x4{0u, 0u, 0u, 0u};
      const size_t off = (size_t)(T0 + t) * 512 + h * 128 + c8;
      if (t < NT) { qv = *(const u32x4*)(Q1 + off); kv = *(const u32x4*)(K1 + off); }
      u32x4 qo, ko;
      float kd[8];
#pragma unroll
      for (int jj = 0; jj < 4; ++jj) {
        float q0 = bflo(qv[jj]), q1 = bfhi(qv[jj]), k0 = bflo(kv[jj]), k1 = bfhi(kv[jj]);
        float e0 = __expf(bb[2 * jj]), e1 = __expf(bb[2 * jj + 1]);
        float i0 = __expf(-bb[2 * jj]), i1 = __expf(-bb[2 * jj + 1]);
        qo[jj] = pk_bf16(q0 * e0, q1 * e1);
        ko[jj] = pk_bf16(k0 * i0, k1 * i1);
        kd[2 * jj] = k0 * __expf(bl[2 * jj] - bb[2 * jj]);
        kd[2 * jj + 1] = k1 * __expf(bl[2 * jj + 1] - bb[2 * jj + 1]);
      }
      if (t < NT) { *(u32x4*)(Q1 + off) = qo; *(u32x4*)(K1 + off) = ko; }
#pragma unroll
      for (int j = 0; j < 8; ++j) kdT[(c8 + j) * 72 + t] = f2bf(kd[j]);
      if (t == 0) {
#pragma unroll
        for (int j = 0; j < 8; ++j) DEC[(size_t)u * 128 + c8 + j] = __expf(bl[j]);
      }
    }
  }
  __syncthreads();
  {
    const int mt = wid & 3, ng = wid >> 2, l31 = lane & 31, hf = lane >> 5;
    bf16x8 a[4];
#pragma unroll
    for (int ks = 0; ks < 4; ++ks) a[ks] = *(const bf16x8*)(kdT + (mt * 32 + l31) * 72 + ks * 16 + hf * 8);
    const u16* VT1 = (const u16*)(ws + W_VT1) + (size_t)u * 16384;
    float* U = (float*)(ws + W_U) + (size_t)u * 32768;
#pragma unroll
    for (int q = 0; q < 4; ++q) {
      const int ntile = ng * 4 + q;
      f32x16 c;
#pragma unroll
      for (int i = 0; i < 16; ++i) c[i] = 0.f;
#pragma unroll
      for (int ks = 0; ks < 4; ++ks) {
        bf16x8 bfr = *(const bf16x8*)(VT1 + (ntile * 32 + l31) * 64 + ks * 16 + hf * 8);
        c = __builtin_amdgcn_mfma_f32_32x32x16_bf16(a[ks], bfr, c, 0, 0, 0);
      }
#pragma unroll
      for (int g = 0; g < 4; ++g) {
        f32x4 o = f32x4{c[4 * g], c[4 * g + 1], c[4 * g + 2], c[4 * g + 3]};
        *(f32x4*)(U + ((size_t)((ntile * 8 + mt * 2 + (g >> 1)) * 64 + (g & 1) * 32 + l31)) * 8 + 4 * hf) = o;
      }
    }
  }
  __syncthreads();
}

DI void swa_unit(const Params& P, const u16* __restrict__ kb, const u16* __restrict__ vb, const int vstride,
                 const int pos0, const int kt_start, const int nkt, const int T0, const int kvh, const int g,
                 const int tofs) {
  char* ws = P.ws;
  const int lane = get_tid() & 63, l31 = lane & 31, hf = lane >> 5;
  const u16* Q2 = (const u16*)(ws + W_Q2);
  const int hc = kvh * 256 + g * 64;
  const size_t qrow = (size_t)(T0 + tofs + l31);
  bf16x8 qf[4];
#pragma unroll
  for (int ks = 0; ks < 4; ++ks) qf[ks] = *(const bf16x8*)(Q2 + qrow * 1024 + hc + ks * 16 + hf * 8);
  f32x16 s[6];
#pragma unroll
  for (int kt = 0; kt < 6; ++kt) {
#pragma unroll
    for (int i = 0; i < 16; ++i) s[kt][i] = -1e30f;
    if (kt >= kt_start && kt < nkt) {
      f32x16 c;
#pragma unroll
      for (int i = 0; i < 16; ++i) c[i] = 0.f;
      const u16* kp = kb + (size_t)(pos0 + kt * 32 + l31) * 64 + hf * 8;
#pragma unroll
      for (int ks = 0; ks < 4; ++ks) {
        bf16x8 kf = *(const bf16x8*)(kp + ks * 16);
        c = __builtin_amdgcn_mfma_f32_32x32x16_bf16(kf, qf[ks], c, 0, 0, 0);
      }
      s[kt] = c;
    }
  }
  const float sink = P.sinks[kvh * 4 + g];
  float mx = sink;
#pragma unroll
  for (int kt = 0; kt < 6; ++kt)
#pragma unroll
    for (int i = 0; i < 16; ++i) mx = fmaxf(mx, s[kt][i]);
  mx = fmaxf(mx, __shfl_xor(mx, 32));
  float sum = 0.f;
#pragma unroll
  for (int kt = 0; kt < 6; ++kt)
#pragma unroll
    for (int i = 0; i < 16; ++i) {
      float p = __expf(s[kt][i] - mx);
      s[kt][i] = p;
      sum += p;
    }
  sum += __shfl_xor(sum, 32);
  sum += __expf(sink - mx);
  const float inv = 1.f / sum;
  f32x16 o[2];
#pragma unroll
  for (int nt2 = 0; nt2 < 2; ++nt2)
#pragma unroll
    for (int i = 0; i < 16; ++i) o[nt2][i] = 0.f;
#pragma unroll
  for (int kt = 0; kt < 6; ++kt) {
    if (kt >= kt_start && kt < nkt) {
#pragma unroll
      for (int sub = 0; sub < 2; ++sub) {
        union { bf16x8 v; unsigned w[4]; } pf;
#pragma unroll
        for (int jj = 0; jj < 4; ++jj)
          pf.w[jj] = pk_bf16(s[kt][sub * 8 + 2 * jj] * inv, s[kt][sub * 8 + 2 * jj + 1] * inv);
        const int key0 = pos0 + kt * 32 + sub * 16 + 4 * hf;
#pragma unroll
        for (int nt2 = 0; nt2 < 2; ++nt2) {
          const u16* vp = vb + (size_t)(nt2 * 32 + l31) * vstride + key0;
          union { bf16x8 v; u32x2 h2[2]; } vf;
          vf.h2[0] = *(const u32x2*)(vp);
          vf.h2[1] = *(const u32x2*)(vp + 8);
          o[nt2] = __builtin_amdgcn_mfma_f32_32x32x16_bf16(pf.v, vf.v, o[nt2], 0, 0, 0);
        }
      }
    }
  }
  const u16* Z2 = (const u16*)(ws + W_Z2);
  u16* MIX = (u16*)(ws + W_MIX);
#pragma unroll
  for (int nt2 = 0; nt2 < 2; ++nt2)
#pragma unroll
    for (int i = 0; i < 16; ++i) {
      const int t = (i & 3) + 8 * (i >> 2) + 4 * hf;
      const size_t row = (size_t)(T0 + tofs + t);
      const int col = hc + nt2 * 32 + l31;
      float z = bf2f(Z2[row * 1024 + col]);
      MIX[row * 2048 + 1024 + col] = f2bf(o[nt2][i] * siluf_(z));
    }
}

DI void phase_mix1() {
  const Params P = load_params();
  char* ws = P.ws;
  const int wid = get_tid() >> 6;
  const int total = NU + 2048 + 32;
  for (int item = blockIdx.x; item < total; item += gridDim.x) {
    if (item < NU) {
      gla_p1_unit(P, item);
    } else if (item < NU + 2048) {
      const int q = item - NU, kvh = q & 3, c = (q >> 2) & 255, b = q >> 10;
      const u16* kb = (const u16*)(ws + W_K2P) + (size_t)(b * 4 + kvh) * 16384 * 64;
      const u16* vb = (const u16*)(ws + W_VT2P) + (size_t)(b * 4 + kvh) * 64 * 16384;
      const int kt_start = c == 0 ? 4 : (c == 1 ? 2 : 0);
      swa_unit(P, kb, vb, 16384, c * 64 - 128, kt_start, 6, b * 16384 + c * 64, kvh, wid >> 1, (wid & 1) * 32);
    } else {
      const int q = item - NU - 2048, kvh = q & 3, sb = q >> 2;
      if (wid < 4) {
        const u16* kb = (const u16*)(ws + W_K2S) + (size_t)(sb * 4 + kvh) * 160 * 64;
        const u16* vb = (const u16*)(ws + W_VT2S) + (size_t)(sb * 4 + kvh) * 64 * 160;
        swa_unit(P, kb, vb, 160, 0, 0, 5, MP + sb * 32, kvh, wid, 0);
      }
    }
  }
}

DI void phase_scan() {
  const Params P = load_params();
  char* ws = P.ws;
  const float* U = (const float*)(ws + W_U);
  u16* S = (u16*)(ws + W_S);
  const float* DEC = (const float*)(ws + W_DEC);
  const int gtid = blockIdx.x * 512 + get_tid(), gsz = gridDim.x * 512;
  for (int item = gtid; item < 8 * 16384; item += gsz) {
    const int sh = item >> 14, q2 = item & 16383;
    const int j0 = (q2 & 3) * 2, ln = (q2 >> 2) & 63, ks = (q2 >> 8) & 7, ntl = q2 >> 11;
    const int dk = ks * 16 + (ln >> 5) * 8 + j0, dv = ntl * 32 + (ln & 31);
    float s0 = 0.f, s1 = 0.f;
    const size_t ubase = (size_t)sh * 256 * 32768 + (size_t)q2 * 2;
    const size_t dbase = (size_t)sh * 256 * 128 + dk;
    for (int c0 = 0; c0 < 256; c0 += 8) {
      float2 uu[8], dd[8];
#pragma unroll
      for (int i = 0; i < 8; ++i) {
        uu[i] = *(const float2*)(U + ubase + (size_t)(c0 + i) * 32768);
        dd[i] = *(const float2*)(DEC + dbase + (size_t)(c0 + i) * 128);
      }
#pragma unroll
      for (int i = 0; i < 8; ++i) {
        *(unsigned*)(S + ubase + (size_t)(c0 + i) * 32768) = pk_bf16(s0, s1);
        s0 = dd[i].x * s0 + uu[i].x;
        s1 = dd[i].y * s1 + uu[i].y;
      }
    }
    float* o = P.out + O_SGP + (size_t)sh * 32768 + (size_t)dk * 256 + dv;
    o[0] = s0;
    o[256] = s1;
  }
  for (int item = gtid; item < 32 * 16384; item += gsz) {
    const int su = item >> 14, q2 = item & 16383;
    const int j0 = (q2 & 3) * 2, ln = (q2 >> 2) & 63, ks = (q2 >> 8) & 7, ntl = q2 >> 11;
    const int dk = ks * 16 + (ln >> 5) * 8 + j0, dv = ntl * 32 + (ln & 31);
    const float2 uu = *(const float2*)(U + (size_t)(2048 + su) * 32768 + (size_t)q2 * 2);
    const float2 dd = *(const float2*)(DEC + (size_t)(2048 + su) * 128 + dk);
    const float* s0p = P.state + (size_t)su * 32768 + (size_t)dk * 256 + dv;
    float* o = P.out + O_SGS + (size_t)su * 32768 + (size_t)dk * 256 + dv;
    o[0] = dd.x * s0p[0] + uu.x;
    o[256] = dd.y * s0p[256] + uu.y;
  }
}

DI void gla_p3_unit(const Params& P, int u) {
  char* ws = P.ws;
  const int tid = get_tid(), lane = tid & 63, w = tid >> 6, l31 = lane & 31, hf = lane >> 5;
  int T0, NT, h;
  if (u < 2048) { int sh = u >> 8, c = u & 255; h = sh & 3; T0 = (sh >> 2) * 16384 + c * 64; NT = 64; }
  else { int su = u - 2048; h = su & 3; T0 = MP + (su >> 2) * 32; NT = 32; }
  const u16* Q1 = (const u16*)(ws + W_Q1);
  const u16* K1 = (const u16*)(ws + W_K1);
  const u16* VT1 = (const u16*)(ws + W_VT1) + (size_t)u * 16384;
  const u16* S = (const u16*)(ws + W_S) + (size_t)u * 32768;
  float* o_s = (float*)smem_raw;
  const bool hi_ok = NT > 32;
  bf16x8 qf[2][8];
#pragma unroll
  for (int ti = 0; ti < 2; ++ti)
#pragma unroll
    for (int ks = 0; ks < 8; ++ks) {
      bf16x8 z;
#pragma unroll
      for (int j = 0; j < 8; ++j) z[j] = 0;
      if (ti == 0 || hi_ok) z = *(const bf16x8*)(Q1 + (size_t)(T0 + ti * 32 + l31) * 512 + h * 128 + ks * 16 + hf * 8);
      qf[ti][ks] = z;
    }
  f32x16 at00, at01, at11;
#pragma unroll
  for (int i = 0; i < 16; ++i) { at00[i] = 0.f; at01[i] = 0.f; at11[i] = 0.f; }
#pragma unroll
  for (int ks = 0; ks < 8; ++ks) {
    bf16x8 kf = *(const bf16x8*)(K1 + (size_t)(T0 + l31) * 512 + h * 128 + ks * 16 + hf * 8);
    at00 = __builtin_amdgcn_mfma_f32_32x32x16_bf16(kf, qf[0][ks], at00, 0, 0, 0);
    at01 = __builtin_amdgcn_mfma_f32_32x32x16_bf16(kf, qf[1][ks], at01, 0, 0, 0);
  }
  if (hi_ok) {
#pragma unroll
    for (int ks = 0; ks < 8; ++ks) {
      bf16x8 kf = *(const bf16x8*)(K1 + (size_t)(T0 + 32 + l31) * 512 + h * 128 + ks * 16 + hf * 8);
      at11 = __builtin_amdgcn_mfma_f32_32x32x16_bf16(kf, qf[1][ks], at11, 0, 0, 0);
    }
  }
  union PF { bf16x8 v; unsigned wd[4]; };
  PF p00[2], p01[2], p11[2];
#pragma unroll
  for (int sub = 0; sub < 2; ++sub)
#pragma unroll
    for (int jj = 0; jj < 4; ++jj) {
      const int i0 = sub * 8 + 2 * jj, i1 = i0 + 1;
      const int s0 = (i0 & 3) + 8 * (i0 >> 2) + 4 * hf, s1 = (i1 & 3) + 8 * (i1 >> 2) + 4 * hf;
      p00[sub].wd[jj] = pk_bf16(s0 <= l31 ? at00[i0] : 0.f, s1 <= l31 ? at00[i1] : 0.f);
      p01[sub].wd[jj] = pk_bf16(at01[i0], at01[i1]);
      p11[sub].wd[jj] = pk_bf16(s0 <= l31 ? at11[i0] : 0.f, s1 <= l31 ? at11[i1] : 0.f);
    }
  f32x16 o0, o1;
#pragma unroll
  for (int i = 0; i < 16; ++i) { o0[i] = 0.f; o1[i] = 0.f; }
  {
    const u16* vp = VT1 + (size_t)(w * 32 + l31) * 64 + 4 * hf;
#pragma unroll
    for (int sub = 0; sub < 2; ++sub) {
      union { bf16x8 v; u32x2 h2[2]; } vf;
      vf.h2[0] = *(const u32x2*)(vp + sub * 16);
      vf.h2[1] = *(const u32x2*)(vp + sub * 16 + 8);
      o0 = __builtin_amdgcn_mfma_f32_32x32x16_bf16(p00[sub].v, vf.v, o0, 0, 0, 0);
      o1 = __builtin_amdgcn_mfma_f32_32x32x16_bf16(p01[sub].v, vf.v, o1, 0, 0, 0);
    }
#pragma unroll
    for (int sub = 0; sub < 2; ++sub) {
      union { bf16x8 v; u32x2 h2[2]; } vf;
      vf.h2[0] = *(const u32x2*)(vp + 32 + sub * 16);
      vf.h2[1] = *(const u32x2*)(vp + 32 + sub * 16 + 8);
      o1 = __builtin_amdgcn_mfma_f32_32x32x16_bf16(p11[sub].v, vf.v, o1, 0, 0, 0);
    }
  }
#pragma unroll
  for (int ks = 0; ks < 8; ++ks) {
    bf16x8 sf = *(const bf16x8*)(S + ((size_t)(w * 8 + ks) * 64 + lane) * 8);
    o0 = __builtin_amdgcn_mfma_f32_32x32x16_bf16(qf[0][ks], sf, o0, 0, 0, 0);
    o1 = __builtin_amdgcn_mfma_f32_32x32x16_bf16(qf[1][ks], sf, o1, 0, 0, 0);
  }
#pragma unroll
  for (int i = 0; i < 16; ++i) {
    const int t = (i & 3) + 8 * (i >> 2) + 4 * hf;
    o_s[t * 260 + w * 32 + l31] = o0[i];
    o_s[(32 + t) * 260 + w * 32 + l31] = o1[i];
  }
  __syncthreads();
  {
    const int row = tid >> 3, seg = tid & 7;
    f32x4 v[8];
    float ss = 0.f;
#pragma unroll
    for (int i = 0; i < 8; ++i) {
      v[i] = *(const f32x4*)(o_s + row * 260 + seg * 32 + i * 4);
      ss += v[i][0] * v[i][0] + v[i][1] * v[i][1] + v[i][2] * v[i][2] + v[i][3] * v[i][3];
    }
    ss += __shfl_xor(ss, 1);
    ss += __shfl_xor(ss, 2);
    ss += __shfl_xor(ss, 4);
    const float rstd = rsqrtf(ss * (1.f / 256.f) + EPS);
    if (row < NT) {
      const size_t trow = (size_t)(T0 + row);
      const u16* zp = (const u16*)(ws + W_Z1) + trow * 1024 + h * 256 + seg * 32;
      u16* mp = (u16*)(ws + W_MIX) + trow * 2048 + h * 256 + seg * 32;
      const float* gg = P.g_gla + seg * 32;
#pragma unroll
      for (int i2 = 0; i2 < 4; ++i2) {
        u32x4 zz = *(const u32x4*)(zp + i2 * 8);
        f32x4 g0 = *(const f32x4*)(gg + i2 * 8), g1 = *(const f32x4*)(gg + i2 * 8 + 4);
        f32x4 a = v[2 * i2], bq = v[2 * i2 + 1];
        u32x4 oo;
        oo[0] = pk_bf16(a[0] * rstd * g0[0] * siluf_(bflo(zz[0])), a[1] * rstd * g0[1] * siluf_(bfhi(zz[0])));
        oo[1] = pk_bf16(a[2] * rstd * g0[2] * siluf_(bflo(zz[1])), a[3] * rstd * g0[3] * siluf_(bfhi(zz[1])));
        oo[2] = pk_bf16(bq[0] * rstd * g1[0] * siluf_(bflo(zz[2])), bq[1] * rstd * g1[1] * siluf_(bfhi(zz[2])));
        oo[3] = pk_bf16(bq[2] * rstd * g1[2] * siluf_(bflo(zz[3])), bq[3] * rstd * g1[3] * siluf_(bfhi(zz[3])));
        *(u32x4*)(mp + i2 * 8) = oo;
      }
    }
  }
  __syncthreads();
}

DI void phase_p3() {
  const Params P = load_params();
  for (int u = blockIdx.x; u < NU; u += gridDim.x) gla_p3_unit(P, u);
}

DI void phase_outproj() {
  const Params P = load_params();
  char* ws = P.ws;
  const u16* MIX = (const u16*)(ws + W_MIX);
  const u16* WOUT = (const u16*)(ws + W_WOUT);
  u16* HB = (u16*)(ws + W_HB);
  float* RSQH = (float*)(ws + W_RSQH);
  int* CNT = (int*)(ws + W_CNT);
  const int tid = get_tid();
  const int wid = __builtin_amdgcn_readfirstlane(tid >> 6), wr = wid >> 2, wc = wid & 3;
  f32x4 acc[2][2][4][2];
  int pm, pn;
  for (int it = 0; next_tile(it, 129, 8, pm, pn); ++it) {
    const int brow = pm * 256, bcol = pn * 256;
    gemm_kloop(MIX, WOUT, 2048, brow, bcol, acc, tid);
    int te = tid;
    asm volatile("" : "+v"(te));
    const int fr = te & 15, fq = (te >> 4) & 3;
#pragma unroll
    for (int ai = 0; ai < 2; ++ai)
#pragma unroll
      for (int m = 0; m < 4; ++m) {
        const int row = brow + ai * 128 + wr * 64 + m * 16 + fr;
        const float* xr = row < MP ? P.x_p + (size_t)row * 2048 : P.x_s + (size_t)(row - MP) * 2048;
        float ss = 0.f;
#pragma unroll
        for (int bj = 0; bj < 2; ++bj)
#pragma unroll
          for (int n = 0; n < 2; ++n) {
            const int col = bcol + bj * 128 + wc * 32 + n * 16 + fq * 4;
            f32x4 hv = acc[ai][bj][m][n] + *(const f32x4*)(xr + col);
            ss += hv[0] * hv[0] + hv[1] * hv[1] + hv[2] * hv[2] + hv[3] * hv[3];
            {
              const unsigned long long pk = (unsigned long long)pk_bf16(hv[0], hv[1]) | ((unsigned long long)pk_bf16(hv[2], hv[3]) << 32);
              __hip_atomic_store((unsigned long long*)(HB + (size_t)row * 2048 + col), pk, __ATOMIC_RELAXED, __HIP_MEMORY_SCOPE_AGENT);
            }
          }
        ss += __shfl_xor(ss, 16);
        ss += __shfl_xor(ss, 32);
        if (fq == 0) unsafeAtomicAdd(RSQH + row, ss);
        __builtin_amdgcn_sched_barrier(0);
      }
    asm volatile("s_waitcnt vmcnt(0)" ::: "memory");
    __syncthreads();
    if (tid == 0) __hip_atomic_fetch_add(CNT + pm, 1, __ATOMIC_RELAXED, __HIP_MEMORY_SCOPE_AGENT);
  }
}

DI void phase_ple() {
  const Params P = load_params();
  char* ws = P.ws;
  const u16* HB = (const u16*)(ws + W_HB);
  const u16* WG = (const u16*)(ws + W_WG);
  const u16* PB = (const u16*)(ws + W_PB);
  const u16* WP = (const u16*)(ws + W_WP);
  const float* RSQH = (const float*)(ws + W_RSQH);
  float* RSQH2 = (float*)(ws + W_RSQH2);
  u16* H2B = (u16*)(ws + W_H2B);
  u32x4* stash = (u32x4*)(ws + W_STASH + (size_t)blockIdx.x * 131072);
  const int tid = get_tid();
  const int wid = __builtin_amdgcn_readfirstlane(tid >> 6), wr = wid >> 2, wc = wid & 3;
  f32x4 acc[2][2][4][2];
  int pm, pn;
  int* CNT = (int*)(ws + W_CNT);
  const int rot = (gridDim.x >= 128) ? 64 : 0;
  for (int it = 0; next_tile(it, 129, 8, pm, pn, rot); ++it) {
    const int brow = pm * 256, bcol = pn * 256;
    if (tid == 0) {
      while (__hip_atomic_load(CNT + pm, __ATOMIC_RELAXED, __HIP_MEMORY_SCOPE_AGENT) < 8) __builtin_amdgcn_s_sleep(4);
      __builtin_amdgcn_fence(__ATOMIC_ACQUIRE, "agent");
    }
    __syncthreads();
    gemm_kloop(HB, WG, 2048, brow, bcol, acc, tid);
    int te = tid;
    asm volatile("" : "+v"(te));
    const int fr = te & 15, fq = (te >> 4) & 3;
#pragma unroll
    for (int ai = 0; ai < 2; ++ai)
#pragma unroll
      for (int m = 0; m < 4; ++m) {
        const int row = brow + ai * 128 + wr * 64 + m * 16 + fr;
        const float rs = rsqrtf(RSQH[row] * (1.f / 2048.f) + EPS);
#pragma unroll
        for (int bj = 0; bj < 2; ++bj) {
          f32x4 a = acc[ai][bj][m][0], bq = acc[ai][bj][m][1];
          u32x4 o;
          o[0] = pk_bf16(sigmoidf_(a[0] * rs), sigmoidf_(a[1] * rs));
          o[1] = pk_bf16(sigmoidf_(a[2] * rs), sigmoidf_(a[3] * rs));
          o[2] = pk_bf16(sigmoidf_(bq[0] * rs), sigmoidf_(bq[1] * rs));
          o[3] = pk_bf16(sigmoidf_(bq[2] * rs), sigmoidf_(bq[3] * rs));
          stash[(size_t)((ai * 4 + m) * 2 + bj) * 512 + te] = o;
        }
        __builtin_amdgcn_sched_barrier(0);
      }
    gemm_kloop(PB, WP, 256, brow, bcol, acc, tid);
    int te2 = tid;
    asm volatile("" : "+v"(te2));
    const int fr2 = te2 & 15, fq2 = (te2 >> 4) & 3;
#pragma unroll
    for (int ai = 0; ai < 2; ++ai)
#pragma unroll
      for (int m = 0; m < 4; ++m) {
        const int row = brow + ai * 128 + wr * 64 + m * 16 + fr2;
        float ss = 0.f;
#pragma unroll
        for (int bj = 0; bj < 2; ++bj) {
          u32x4 gt = stash[(size_t)((ai * 4 + m) * 2 + bj) * 512 + te2];
#pragma unroll
          for (int n = 0; n < 2; ++n) {
            const int col = bcol + bj * 128 + wc * 32 + n * 16 + fq2 * 4;
            const u32x2 hraw = *(const u32x2*)(HB + (size_t)row * 2048 + col);
            f32x4 hv = f32x4{bflo(hraw[0]), bfhi(hraw[0]), bflo(hraw[1]), bfhi(hraw[1])};
            f32x4 pp = acc[ai][bj][m][n];
            f32x4 gv = f32x4{bflo(gt[2 * n]), bfhi(gt[2 * n]), bflo(gt[2 * n + 1]), bfhi(gt[2 * n + 1])};
            f32x4 h2 = hv + gv * pp;
            ss += h2[0] * h2[0] + h2[1] * h2[1] + h2[2] * h2[2] + h2[3] * h2[3];
            store_bf4(H2B + (size_t)row * 2048 + col, h2);
          }
        }
        ss += __shfl_xor(ss, 16);
        ss += __shfl_xor(ss, 32);
        if (fq2 == 0) unsafeAtomicAdd(RSQH2 + row, ss);
        __builtin_amdgcn_sched_barrier(0);
      }
  }
}

DI void phase_final() {
  const Params P = load_params();
  const float* RSQH2 = (const float*)(P.ws + W_RSQH2);
  const u16* H2B = (const u16*)(P.ws + W_H2B);
  const size_t n8 = (size_t)MT * 256;
  for (size_t i = (size_t)blockIdx.x * 512 + get_tid(); i < n8; i += (size_t)gridDim.x * 512) {
    const int row = (int)(i >> 8), c8 = (int)(i & 255);
    const float rs = rsqrtf(RSQH2[row] * (1.f / 2048.f) + EPS);
    const u32x4 hv = ((const u32x4*)H2B)[i];
    const f32x4 g0 = ((const f32x4*)P.g_final)[c8 * 2], g1 = ((const f32x4*)P.g_final)[c8 * 2 + 1];
    f32x4 o0 = f32x4{bflo(hv[0]), bfhi(hv[0]), bflo(hv[1]), bfhi(hv[1])} * rs * g0;
    f32x4 o1 = f32x4{bflo(hv[2]), bfhi(hv[2]), bflo(hv[3]), bfhi(hv[3])} * rs * g1;
    f32x4* op = (f32x4*)(P.out + O_Y) + i * 2;
    op[0] = o0;
    op[1] = o1;
  }
}

__global__ void __launch_bounds__(512, 2) hymba_megakernel(Params Pk) {
  cg::grid_group grid = cg::this_grid();
  const int ph_lo = Pk.ph_lo, ph_hi = Pk.ph_hi;
#ifndef PROBE_MASK
#define PROBE_MASK 0
#endif
#define PROBE_MULT 2
#define RUN_PHASE(ph, call)                                   \
  if (ph_lo <= ph && ph < ph_hi) {                            \
    if (ph > ph_lo) grid.sync();                              \
    long long t0_ = 0;                                        \
    if (PROBE_MASK) t0_ = wall_clock64();                     \
    call;                                                     \
    if ((PROBE_MASK >> ph) & 1) {                             \
      if (ph == 7) __syncthreads();                           \
      probe_acc += wall_clock64() - t0_;                      \
    }                                                         \
  }
  long long probe_acc = 0;
  RUN_PHASE(0, phase_prep())
  RUN_PHASE(1, phase_inproj())
  RUN_PHASE(2, phase_mix1())
  RUN_PHASE(3, phase_scan())
  RUN_PHASE(4, phase_p3())
  RUN_PHASE(5, (phase_outproj(), phase_ple()))
  RUN_PHASE(7, phase_final())
  if (PROBE_MASK) {
    const long long tend = wall_clock64() + PROBE_MULT * probe_acc;
    while (wall_clock64() < tend) __builtin_amdgcn_s_sleep(8);
  }
}

extern "C" void kernel_launch(void* const* d_in, const int* in_sizes, int n_in, void* d_out, int out_size, void* d_ws,
                              size_t ws_size, hipStream_t stream) {
  static int grid_blocks = 0;
  if (!grid_blocks) {
    hipFuncSetAttribute((const void*)hymba_megakernel, hipFuncAttributeMaxDynamicSharedMemorySize, SHM_B);
    int dev = 0, cus = 0, per_cu = 0;
    hipGetDevice(&dev);
    hipDeviceGetAttribute(&cus, hipDeviceAttributeMultiprocessorCount, dev);
    hipOccupancyMaxActiveBlocksPerMultiprocessor(&per_cu, hymba_megakernel, 512, SHM_B);
    if (per_cu < 1) per_cu = 1;
    if (per_cu > 1) per_cu = 1;
    grid_blocks = cus * per_cu;
  }
  Params p{};
  p.x_p = (const float*)d_in[0]; p.x_s = (const float*)d_in[1]; p.p_p = (const float*)d_in[2];
  p.p_s = (const float*)d_in[3]; p.state = (const float*)d_in[4]; p.ck = (const float*)d_in[5];
  p.cv = (const float*)d_in[6]; p.g_mix = (const float*)d_in[7]; p.w_in = (const float*)d_in[8];
  p.w_gu = (const float*)d_in[9]; p.b_gate = (const float*)d_in[10]; p.g_gla = (const float*)d_in[11];
  p.sinks = (const float*)d_in[12]; p.w_out = (const float*)d_in[13]; p.g_ple = (const float*)d_in[14];
  p.w_pg = (const float*)d_in[15]; p.w_pp = (const float*)d_in[16]; p.g_final = (const float*)d_in[17];
  p.out = (float*)d_out;
  p.ws = (char*)d_ws;
  p.ph_lo = 0;
  p.ph_hi = 8;
  void* args[] = {&p};
  hipError_t e = hipLaunchCooperativeKernel((const void*)hymba_megakernel, dim3(grid_blocks), dim3(512), args, SHM_B, stream);
  if (e != hipSuccess) fprintf(stderr, "cooperative launch failed: %s (grid %d)\n", hipGetErrorString(e), grid_blocks);
}
```

```cpp
#include <hip/hip_runtime.h>
#include <hip/hip_cooperative_groups.h>
#include <cstdio>
namespace cg = cooperative_groups;

typedef unsigned short u16;
using bf16x8 = __attribute__((ext_vector_type(8))) short;
using f32x4 = __attribute__((ext_vector_type(4))) float;
using f32x16 = __attribute__((ext_vector_type(16))) float;
using u32x2 = __attribute__((ext_vector_type(2))) unsigned;
using u32x4 = __attribute__((ext_vector_type(4))) unsigned;

#define DI __device__ __forceinline__

constexpr int MP = 32768, MS = 256, MT = MP + MS;
constexpr int LSEQ = 16384, DM = 2048;
constexpr int NIN = 5888;
constexpr int NU = 2080;
constexpr float EPS = 1e-6f;

constexpr size_t O_Y = 0;
constexpr size_t O_SGP = (size_t)MT * 2048;
constexpr size_t O_KP = O_SGP + 262144;
constexpr size_t O_VP = O_KP + 65536;
constexpr size_t O_SGS = O_VP + 65536;
constexpr size_t O_KS = O_SGS + 1048576;
constexpr size_t O_VS = O_KS + 65536;

constexpr size_t al256(size_t x) { return (x + 255) & ~(size_t)255; }
constexpr size_t W_XB = 0;
constexpr size_t W_PB = W_XB + al256((size_t)MT * 2048 * 2);
constexpr size_t W_WIN = W_PB + al256((size_t)MT * 256 * 2);
constexpr size_t W_WOUT = W_WIN + al256((size_t)NIN * 2048 * 2);
constexpr size_t W_WG = W_WOUT + al256((size_t)2048 * 2048 * 2);
constexpr size_t W_WP = W_WG + al256((size_t)2048 * 2048 * 2);
constexpr size_t W_RSTDX = W_WP + al256((size_t)2048 * 256 * 2);
constexpr size_t W_Q1 = W_RSTDX + al256((size_t)MT * 4);
constexpr size_t W_K1 = W_Q1 + al256((size_t)MT * 512 * 2);
constexpr size_t W_VT1 = W_K1 + al256((size_t)MT * 512 * 2);
constexpr size_t W_Z1 = W_VT1 + al256((size_t)NU * 256 * 64 * 2);
constexpr size_t W_Q2 = W_Z1 + al256((size_t)MT * 1024 * 2);
constexpr size_t W_K2P = W_Q2 + al256((size_t)MT * 1024 * 2);
constexpr size_t W_K2S = W_K2P + al256((size_t)8 * 16384 * 64 * 2);
constexpr size_t W_VT2P = W_K2S + al256((size_t)32 * 160 * 64 * 2);
constexpr size_t W_VT2S = W_VT2P + al256((size_t)8 * 64 * 16384 * 2);
constexpr size_t W_Z2 = W_VT2S + al256((size_t)32 * 64 * 160 * 2);
constexpr size_t W_LR = W_Z2 + al256((size_t)MT * 1024 * 2);
constexpr size_t W_U = W_LR + al256((size_t)MT * 16 * 4);
constexpr size_t W_S = W_U + al256((size_t)NU * 32768 * 4);
constexpr size_t W_DEC = W_S + al256((size_t)NU * 32768 * 2);
constexpr size_t W_RSQH = W_DEC + al256((size_t)NU * 128 * 4);
constexpr size_t W_RSQH2 = W_RSQH + al256((size_t)MT * 32 * 4);
constexpr size_t W_CNT = W_RSQH2 + al256((size_t)MT * 32 * 4);
constexpr size_t W_END = W_CNT + 1024;
constexpr size_t W_MIX = W_XB;
constexpr size_t W_H2B = W_XB;
constexpr size_t W_HB = W_Q1;
constexpr size_t W_STASH = W_Z1;
static_assert(W_HB + (size_t)MT * 2048 * 2 <= W_Z1, "HB alias overflow");
static_assert(W_END <= (size_t)1073741824, "workspace too large");

struct Params {
  const float *x_p, *x_s, *p_p, *p_s, *state, *ck, *cv, *g_mix, *w_in, *w_gu, *b_gate, *g_gla, *sinks, *w_out,
      *g_ple, *w_pg, *w_pp, *g_final;
  float* out;
  char* ws;
  int ph_lo, ph_hi;
};

extern __shared__ __attribute__((aligned(16))) unsigned char smem_raw[];

typedef const __attribute__((address_space(4))) Params* KParamsPtr;
__device__ __forceinline__ Params load_params() {
  KParamsPtr kp = (KParamsPtr)__builtin_amdgcn_kernarg_segment_ptr();
  asm volatile("" : "+s"(kp));
  Params r;
  r.x_p = kp->x_p; r.x_s = kp->x_s; r.p_p = kp->p_p; r.p_s = kp->p_s; r.state = kp->state; r.ck = kp->ck; r.cv = kp->cv;
  r.g_mix = kp->g_mix; r.w_in = kp->w_in; r.w_gu = kp->w_gu; r.b_gate = kp->b_gate; r.g_gla = kp->g_gla;
  r.sinks = kp->sinks; r.w_out = kp->w_out; r.g_ple = kp->g_ple; r.w_pg = kp->w_pg; r.w_pp = kp->w_pp;
  r.g_final = kp->g_final; r.out = kp->out; r.ws = kp->ws; r.ph_lo = kp->ph_lo; r.ph_hi = kp->ph_hi;
  return r;
}

DI unsigned pk_bf16(float a, float b) {
  unsigned r;
  asm("v_cvt_pk_bf16_f32 %0, %1, %2" : "=v"(r) : "v"(a), "v"(b));
  return r;
}
DI u16 f2bf(float a) { return (u16)(pk_bf16(a, 0.f) & 0xffffu); }
DI float bf2f(u16 v) { return __uint_as_float(((unsigned)v) << 16); }
DI float bflo(unsigned v) { return __uint_as_float(v << 16); }
DI float bfhi(unsigned v) { return __uint_as_float(v & 0xffff0000u); }
DI float sigmoidf_(float x) { return 1.f / (1.f + __expf(-x)); }
DI float siluf_(float x) { return x / (1.f + __expf(-x)); }
DI int get_tid() {
  int t = threadIdx.x;
  asm volatile("" : "+v"(t));
  return t;
}
DI float wave_sum(float v) {
#pragma unroll
  for (int o = 32; o >= 1; o >>= 1) v += __shfl_xor(v, o);
  return v;
}

constexpr int BM = 256, BK = 64, HALF = 128, HT = HALF * BK;
constexpr int SHM_B = 8 * HT * 2;

DI int lds_byte(int r, int c) {
  int st = (r >> 4) * 2 + (c >> 5), rr = r & 15, cc = c & 31, ob = rr * 64 + cc * 2;
  return st * 1024 + (ob ^ (((ob >> 9) & 1) << 5));
}
DI void stage_rc(int b, int& R, int& C) {
  int st = b / 1024, sb = b % 1024, swz = sb ^ (((sb >> 9) & 1) << 5);
  R = (st >> 1) * 16 + swz / 64;
  C = (st & 1) * 32 + (swz % 64) / 2;
}

DI void gemm_kloop(const u16* __restrict__ A, const u16* __restrict__ Bt, const int K, const int brow, const int bcol,
                   f32x4 (&acc)[2][2][4][2], const int tid_) {
  u16* shm = (u16*)smem_raw;
#define SA(b, h) (shm + ((b)*2 + (h)) * HT)
#define SB(b, h) (shm + (4 + (b)*2 + (h)) * HT)
#define STAGE(P, BASE, br, kt)                                                                       \
  do {                                                                                               \
    const char* _gb = (const char*)(BASE + ((size_t)(br)*K + (size_t)(kt)*BK));                      \
    asm volatile("" : "+s"(_gb));                                                                    \
    __builtin_amdgcn_global_load_lds((const unsigned*)(_gb + (size_t)so0),                           \
                                     (__attribute__((address_space(3))) unsigned*)((char*)(P) + lw), 16, 0, 0); \
    __builtin_amdgcn_global_load_lds((const unsigned*)(_gb + (size_t)so1),                           \
                                     (__attribute__((address_space(3))) unsigned*)((char*)(P) + lw + 8192), 16, 0, 0); \
  } while (0)
#define LDA(dst, b, h)                                                                               \
  for (int m = 0; m < 4; ++m)                                                                        \
    for (int k = 0; k < 2; ++k)                                                                      \
  dst[m][k] = *reinterpret_cast<const bf16x8*>((char*)SA(b, h) + lds_byte(wr * 64 + m * 16 + fr, k * 32 + fq * 8))
#define LDB(dst, b, h)                                                                               \
  for (int n = 0; n < 2; ++n)                                                                        \
    for (int k = 0; k < 2; ++k)                                                                      \
  dst[n][k] = *reinterpret_cast<const bf16x8*>((char*)SB(b, h) + lds_byte(wc * 32 + n * 16 + fr, k * 32 + fq * 8))
#define MMA(ai, bj, At_, Bt_)                                                                        \
  do {                                                                                               \
    __builtin_amdgcn_s_setprio(1);                                                                   \
    for (int m = 0; m < 4; ++m)                                                                      \
      for (int n = 0; n < 2; ++n)                                                                    \
        for (int k = 0; k < 2; ++k)                                                                  \
          acc[ai][bj][m][n] = __builtin_amdgcn_mfma_f32_16x16x32_bf16(Bt_[n][k], At_[m][k], acc[ai][bj][m][n], 0, 0, 0); \
    __builtin_amdgcn_s_setprio(0);                                                                   \
  } while (0)
#define WAIT_V(n) asm volatile("s_waitcnt vmcnt(" #n ")" ::: "memory")
#define WAIT_L(n) asm volatile("s_waitcnt lgkmcnt(" #n ")" ::: "memory")
#define BAR __builtin_amdgcn_s_barrier()
#define SCHED __builtin_amdgcn_sched_barrier(0)

  const int wid = __builtin_amdgcn_readfirstlane(tid_ >> 6), lane = tid_ & 63, wr = wid >> 2, wc = wid & 3, fr = lane & 15, fq = lane >> 4;
  const int sb0 = tid_ * 16;
  unsigned so0, so1;
  {
    int r_, c_;
    stage_rc(sb0, r_, c_);
    so0 = (unsigned)(r_ * K + c_) * 2u;
    stage_rc(sb0 + 8192, r_, c_);
    so1 = (unsigned)(r_ * K + c_) * 2u;
  }
  const int lw = wid * 1024;
#pragma unroll
  for (int a = 0; a < 2; ++a)
#pragma unroll
    for (int b = 0; b < 2; ++b)
#pragma unroll
      for (int m = 0; m < 4; ++m)
#pragma unroll
        for (int n = 0; n < 2; ++n) acc[a][b][m][n] = f32x4{0.f, 0.f, 0.f, 0.f};
  bf16x8 At[4][2], B0[2][2], B1[2][2];
  const int nt = K / BK;
  STAGE(SB(0, 0), Bt, bcol, 0);
  STAGE(SA(0, 0), A, brow, 0);
  STAGE(SB(0, 1), Bt, bcol + HALF, 0);
  STAGE(SA(0, 1), A, brow + HALF, 0);
  if (wr == 1) BAR;
  WAIT_V(4);
  BAR;
  STAGE(SB(1, 0), Bt, bcol, 1);
  STAGE(SA(1, 0), A, brow, 1);
  STAGE(SB(1, 1), Bt, bcol + HALF, 1);
  WAIT_V(6);
  BAR;
  for (int t = 0; t < nt - 2; t += 2) {
    LDB(B0, 0, 0); SCHED; LDA(At, 0, 0); STAGE(SA(1, 1), A, brow + HALF, t + 1);
    WAIT_L(8); BAR; WAIT_L(0); MMA(0, 0, At, B0); BAR; SCHED;
    LDB(B1, 0, 1); STAGE(SB(0, 0), Bt, bcol, t + 2);
    BAR; WAIT_L(0); MMA(0, 1, At, B1); BAR;
    LDA(At, 0, 1); STAGE(SA(0, 0), A, brow, t + 2);
    BAR; WAIT_L(0); MMA(1, 0, At, B0); BAR; SCHED;
    STAGE(SB(0, 1), Bt, bcol + HALF, t + 2);
    WAIT_V(6); BAR; MMA(1, 1, At, B1); BAR;
    LDB(B0, 1, 0); SCHED; LDA(At, 1, 0); STAGE(SA(0, 1), A, brow + HALF, t + 2);
    WAIT_L(8); BAR; WAIT_L(0); MMA(0, 0, At, B0); BAR; SCHED;
    LDB(B1, 1, 1); STAGE(SB(1, 0), Bt, bcol, t + 3);
    BAR; WAIT_L(0); MMA(0, 1, At, B1); BAR;
    LDA(At, 1, 1); STAGE(SA(1, 0), A, brow, t + 3);
    BAR; WAIT_L(0); MMA(1, 0, At, B0); BAR; SCHED;
    STAGE(SB(1, 1), Bt, bcol + HALF, t + 3);
    WAIT_V(6); BAR; MMA(1, 1, At, B1); BAR;
  }
  {
    LDB(B0, 0, 0); LDA(At, 0, 0); STAGE(SA(1, 1), A, brow + HALF, nt - 1);
    BAR; WAIT_L(0); MMA(0, 0, At, B0); BAR;
    LDB(B1, 0, 1); BAR; WAIT_L(0); MMA(0, 1, At, B1); BAR;
    LDA(At, 0, 1); WAIT_V(4); BAR; WAIT_L(0); MMA(1, 0, At, B0); MMA(1, 1, At, B1); BAR;
  }
  {
    LDB(B0, 1, 0); LDA(At, 1, 0); WAIT_V(2); BAR; WAIT_L(0); MMA(0, 0, At, B0); BAR;
    LDB(B1, 1, 1); WAIT_V(0); BAR; WAIT_L(0); MMA(0, 1, At, B1); BAR;
    LDA(At, 1, 1); BAR; WAIT_L(0); MMA(1, 0, At, B0); MMA(1, 1, At, B1); BAR;
  }
  if (wr == 0) BAR;
#undef SA
#undef SB
#undef STAGE
#undef LDA
#undef LDB
#undef MMA
}

DI bool next_tile(int it, int nM, int nN, int& pm, int& pn, int rot = 0) {
  const int nb = gridDim.x;
  int bid = blockIdx.x + rot;
  if (bid >= nb) bid -= nb;
  int tl;
  if ((nb & 7) == 0) {
    int nloc = nb >> 3;
    tl = (it * 8 + (bid & 7)) * nloc + (bid >> 3);
  } else {
    tl = it * nb + bid;
  }
  if (tl >= nM * nN) return false;
  int nig = 8 * nN, g = tl / nig, rem = tl - g * nig, gsz = min(8, nM - g * 8);
  pm = g * 8 + rem % gsz;
  pn = rem / gsz;
  return true;
}

DI void transpose_task(const float* __restrict__ src, int ldsrc, int K, int n0, int k0, u16* __restrict__ dst,
                       const float* __restrict__ gvec, int mode, int lane) {
  const int np = n0 + lane;
  int scol = np;
  float cs = 1.f;
  bool valid = true;
  if (mode == 1) {
    if (np < 3072) scol = np;
    else if (np < 5632) scol = np + 16;
    else if (np < 5648) scol = 3072 + (np - 5632);
    else { valid = false; scol = 0; }
    if (np < 512) cs = 0.08838834764831845f;
    else if (np >= 3072 && np < 4096) cs = 0.125f;
  }
  if (!valid) cs = 0.f;
  const float* sp = src + (size_t)k0 * ldsrc + scol;
  u16* dp = dst + (size_t)np * K + k0;
#pragma unroll 2
  for (int k8 = 0; k8 < 16; ++k8) {
    float v[8];
#pragma unroll
    for (int j = 0; j < 8; ++j) v[j] = sp[(size_t)(k8 * 8 + j) * ldsrc];
    if (gvec) {
#pragma unroll
      for (int j = 0; j < 8; ++j) v[j] *= gvec[k0 + k8 * 8 + j];
    }
    u32x4 o;
    o[0] = pk_bf16(v[0] * cs, v[1] * cs);
    o[1] = pk_bf16(v[2] * cs, v[3] * cs);
    o[2] = pk_bf16(v[4] * cs, v[5] * cs);
    o[3] = pk_bf16(v[6] * cs, v[7] * cs);
    *(u32x4*)(dp + k8 * 8) = o;
  }
}

DI void phase_prep() {
  const Params P = load_params();
  const int tid = get_tid(), lane = tid & 63, wid = tid >> 6, nb = gridDim.x, bid = blockIdx.x;
  char* ws = P.ws;
  u16* XB = (u16*)(ws + W_XB);
  u16* PB = (u16*)(ws + W_PB);
  float* RSTDX = (float*)(ws + W_RSTDX);
  float* RSQH = (float*)(ws + W_RSQH);
  float* RSQH2 = (float*)(ws + W_RSQH2);
  for (int g = bid * 8 + wid; g < MT / 4; g += nb * 8) {
    const int r0 = g * 4;
    const float* xr = r0 < MP ? P.x_p + (size_t)r0 * 2048 : P.x_s + (size_t)(r0 - MP) * 2048;
    const float* pr = r0 < MP ? P.p_p + (size_t)r0 * 256 : P.p_s + (size_t)(r0 - MP) * 256;
    f32x4 v[4][8], pv[4];
#pragma unroll
    for (int j = 0; j < 4; ++j) {
#pragma unroll
      for (int it = 0; it < 8; ++it) v[j][it] = __builtin_nontemporal_load((const f32x4*)(xr + (size_t)j * 2048) + it * 64 + lane);
      pv[j] = __builtin_nontemporal_load((const f32x4*)(pr + (size_t)j * 256) + lane);
    }
#pragma unroll
    for (int j = 0; j < 4; ++j) {
      const int r = r0 + j;
      float ss = 0.f;
      u16* xb = XB + (size_t)r * 2048;
#pragma unroll
      for (int it = 0; it < 8; ++it) {
        f32x4 w = v[j][it];
        ss += w[0] * w[0] + w[1] * w[1] + w[2] * w[2] + w[3] * w[3];
        u32x2 o;
        o[0] = pk_bf16(w[0], w[1]);
        o[1] = pk_bf16(w[2], w[3]);
        ((u32x2*)xb)[it * 64 + lane] = o;
      }
      ss = wave_sum(ss);
      {
        u32x2 o;
        o[0] = pk_bf16(pv[j][0], pv[j][1]);
        o[1] = pk_bf16(pv[j][2], pv[j][3]);
        ((u32x2*)(PB + (size_t)r * 256))[lane] = o;
      }
      if (lane == 0) {
        RSTDX[r] = rsqrtf(ss * (1.f / 2048.f) + EPS);
      }
    }
  }
  if (bid == 0 && tid < 256) ((int*)(ws + W_CNT))[tid] = 0;
  {
    const int T_IN = 92 * 16, T_OUT = 32 * 16, T_G = 32 * 16, T_P = 32 * 2;
    const int TT = T_IN + T_OUT + T_G + T_P;
    for (int tl = bid * 8 + wid; tl < TT; tl += nb * 8) {
      if (tl < T_IN) {
        int nt_ = tl / 16, kt_ = tl % 16;
        transpose_task(P.w_in, 5648, 2048, nt_ * 64, kt_ * 128, (u16*)(ws + W_WIN), P.g_mix, 1, lane);
      } else if (tl < T_IN + T_OUT) {
        int q = tl - T_IN, nt_ = q / 16, kt_ = q % 16;
        transpose_task(P.w_out, 2048, 2048, nt_ * 64, kt_ * 128, (u16*)(ws + W_WOUT), nullptr, 0, lane);
      } else if (tl < T_IN + T_OUT + T_G) {
        int q = tl - T_IN - T_OUT, nt_ = q / 16, kt_ = q % 16;
        transpose_task(P.w_pg, 2048, 2048, nt_ * 64, kt_ * 128, (u16*)(ws + W_WG), P.g_ple, 0, lane);
      } else {
        int q = tl - T_IN - T_OUT - T_G, nt_ = q / 2, kt_ = q % 2;
        transpose_task(P.w_pp, 2048, 256, nt_ * 64, kt_ * 128, (u16*)(ws + W_WP), nullptr, 0, lane);
      }
    }
  }
  const int gtid = bid * 512 + tid, gsz = nb * 512;
  {
    u16* K2S = (u16*)(ws + W_K2S);
    u16* VT2S = (u16*)(ws + W_VT2S);
    for (int i = gtid; i < 8 * 128 * 4 * 64; i += gsz) {
      int sb = i >> 15, pos = (i >> 8) & 127, kvh = (i >> 6) & 3, d = i & 63;
      K2S[((size_t)(sb * 4 + kvh) * 160 + pos) * 64 + d] = f2bf(P.ck[i]);
      VT2S[((size_t)(sb * 4 + kvh) * 64 + d) * 160 + pos] = f2bf(P.cv[i]);
    }
  }
  {
    u32x4* z = (u32x4*)((u16*)(ws + W_VT1) + (size_t)2048 * 16384);
    for (int i = gtid; i < 32 * 16384 / 8; i += gsz) z[i] = u32x4{0u, 0u, 0u, 0u};
  }
  {
    u16* S = (u16*)(ws + W_S) + (size_t)2048 * 32768;
    for (int i = gtid; i < 32 * 4096; i += gsz) {
      int su = i >> 12, q = i & 4095;
      int ln = q & 63, ks = (q >> 6) & 7, ntl = q >> 9;
      int dv = ntl * 32 + (ln & 31), dk0 = ks * 16 + (ln >> 5) * 8;
      const float* src = P.state + (size_t)su * 32768 + (size_t)dk0 * 256 + dv;
      u32x4 o;
      o[0] = pk_bf16(src[0], src[256]);
      o[1] = pk_bf16(src[512], src[768]);
      o[2] = pk_bf16(src[1024], src[1280]);
      o[3] = pk_bf16(src[1536], src[1792]);
      ((u32x4*)(S + (size_t)su * 32768))[q] = o;
    }
  }
}

DI void store_bf4(u16* p, f32x4 v) {
  u32x2 o;
  o[0] = pk_bf16(v[0], v[1]);
  o[1] = pk_bf16(v[2], v[3]);
  *(u32x2*)p = o;
}

DI void phase_inproj() {
  const Params P = load_params();
  char* ws = P.ws;
  const u16* XB = (const u16*)(ws + W_XB);
  const u16* WIN = (const u16*)(ws + W_WIN);
  const float* RSTDX = (const float*)(ws + W_RSTDX);
  const int tid = get_tid();
  const int wid = __builtin_amdgcn_readfirstlane(tid >> 6), wr = wid >> 2, wc = wid & 3;
  f32x4 acc[2][2][4][2];
  int pm, pn;
  for (int it = 0; next_tile(it, 129, 23, pm, pn); ++it) {
    const int brow = pm * 256, bcol = pn * 256;
    gemm_kloop(XB, WIN, 2048, brow, bcol, acc, tid);
    int te = tid;
    asm volatile("" : "+v"(te));
    const int fr = te & 15, fq = (te >> 4) & 3;
    int kind = 0, ld = 512, coff = 0;
    u16* dst = (u16*)(ws + W_Q1);
    if (pn < 2) { coff = pn * 256; }
    else if (pn < 4) { dst = (u16*)(ws + W_K1); coff = (pn - 2) * 256; }
    else if (pn < 8) { kind = 1; }
    else if (pn < 12) { dst = (u16*)(ws + W_Z1); ld = 1024; coff = (pn - 8) * 256; }
    else if (pn < 16) { dst = (u16*)(ws + W_Q2); ld = 1024; coff = (pn - 12) * 256; }
    else if (pn == 16) { kind = 2; }
    else if (pn == 17) { kind = 3; }
    else if (pn < 22) { dst = (u16*)(ws + W_Z2); ld = 1024; coff = (pn - 18) * 256; }
    else { kind = 4; }
    const int cb = wc * 32 + fq * 4;
    float rsv[8];
#pragma unroll
    for (int g = 0; g < 8; ++g) rsv[g] = RSTDX[brow + (g >> 2) * 128 + wr * 64 + (g & 3) * 16 + fr];
    if (kind == 0) {
#pragma unroll
      for (int ai = 0; ai < 2; ++ai)
#pragma unroll
        for (int m = 0; m < 4; ++m) {
          const int row = brow + ai * 128 + wr * 64 + m * 16 + fr;
          const float rs = rsv[ai * 4 + m];
          u16* dp = dst + (size_t)row * ld + coff + cb;
#pragma unroll
          for (int bj = 0; bj < 2; ++bj)
#pragma unroll
            for (int n = 0; n < 2; ++n) store_bf4(dp + bj * 128 + n * 16, acc[ai][bj][m][n] * rs);
          __builtin_amdgcn_sched_barrier(0);
        }
    } else if (kind == 1) {
      const int h = pn - 4;
#pragma unroll
      for (int ai = 0; ai < 2; ++ai)
#pragma unroll
        for (int m = 0; m < 4; ++m) {
          const int row = brow + ai * 128 + wr * 64 + m * 16 + fr;
          const float rs = rsv[ai * 4 + m];
          int unit, t;
          if (row < MP) { unit = ((row >> 14) * 4 + h) * 256 + ((row & 16383) >> 6); t = row & 63; }
          else { unit = 2048 + ((row - MP) >> 5) * 4 + h; t = (row - MP) & 31; }
          u16* dp = (u16*)(ws + W_VT1) + ((size_t)unit * 256 + cb) * 64 + t;
#pragma unroll
          for (int bj = 0; bj < 2; ++bj)
#pragma unroll
            for (int n = 0; n < 2; ++n) {
              f32x4 v = acc[ai][bj][m][n] * rs;
              u16* d = dp + (bj * 128 + n * 16) * 64;
              d[0] = f2bf(v[0]); d[64] = f2bf(v[1]); d[128] = f2bf(v[2]); d[192] = f2bf(v[3]);
            }
          __builtin_amdgcn_sched_barrier(0);
        }
    } else if (kind == 2 || kind == 3) {
#pragma unroll
      for (int ai = 0; ai < 2; ++ai)
#pragma unroll
        for (int m = 0; m < 4; ++m) {
          const int row = brow + ai * 128 + wr * 64 + m * 16 + fr;
          const float rs = rsv[ai * 4 + m];
          const bool isP = row < MP;
          const int b = row >> 14, pos = row & 16383;
          const int sT = row - MP, sb = sT >> 5, st = sT & 31;
#pragma unroll
          for (int bj = 0; bj < 2; ++bj)
#pragma unroll
            for (int n = 0; n < 2; ++n) {
              f32x4 v = acc[ai][bj][m][n] * rs;
              const int col = bj * 128 + n * 16 + cb;
              const int kvh = col >> 6, d0 = col & 63;
              if (kind == 2) {
                if (isP) {
                  store_bf4((u16*)(ws + W_K2P) + ((size_t)(b * 4 + kvh) * 16384 + pos) * 64 + d0, v);
                  if (pos >= LSEQ - 128)
                    *(f32x4*)(P.out + O_KP + ((size_t)(b * 128 + pos - (LSEQ - 128)) * 4 + kvh) * 64 + d0) = v;
                } else {
                  store_bf4((u16*)(ws + W_K2S) + ((size_t)(sb * 4 + kvh) * 160 + 128 + st) * 64 + d0, v);
                  *(f32x4*)(P.out + O_KS + (size_t)sT * 256 + col) = v;
                }
              } else {
                if (isP) {
                  u16* d = (u16*)(ws + W_VT2P) + ((size_t)(b * 4 + kvh) * 64 + d0) * 16384 + pos;
                  d[0] = f2bf(v[0]); d[16384] = f2bf(v[1]); d[32768] = f2bf(v[2]); d[49152] = f2bf(v[3]);
                  if (pos >= LSEQ - 128)
                    *(f32x4*)(P.out + O_VP + ((size_t)(b * 128 + pos - (LSEQ - 128)) * 4 + kvh) * 64 + d0) = v;
                } else {
                  u16* d = (u16*)(ws + W_VT2S) + ((size_t)(sb * 4 + kvh) * 64 + d0) * 160 + 128 + st;
                  d[0] = f2bf(v[0]); d[160] = f2bf(v[1]); d[320] = f2bf(v[2]); d[480] = f2bf(v[3]);
                  *(f32x4*)(P.out + O_VS + (size_t)sT * 256 + col) = v;
                }
              }
            }
          __builtin_amdgcn_sched_barrier(0);
        }
    } else {
      if (wc == 0 && fq < 4) {
#pragma unroll
        for (int ai = 0; ai < 2; ++ai)
#pragma unroll
          for (int m = 0; m < 4; ++m) {
            const int row = brow + ai * 128 + wr * 64 + m * 16 + fr;
            const float rs = rsv[ai * 4 + m];
            *(f32x4*)((float*)(ws + W_LR) + (size_t)row * 16 + fq * 4) = acc[ai][0][m][0] * rs;
          }
      }
    }
  }
}

DI void gla_p1_unit(const Params& P, int u) {
  char* ws = P.ws;
  const int tid = get_tid(), lane = tid & 63, wid = tid >> 6;
  float* lr_s = (float*)smem_raw;
  float* b_s = (float*)(smem_raw + 4096);
  float* seg_s = (float*)(smem_raw + 4096 + 32768);
  u16* kdT = (u16*)(smem_raw + 4096 + 32768 + 2048);
  int T0, NT, h;
  if (u < 2048) { int sh = u >> 8, c = u & 255; h = sh & 3; T0 = (sh >> 2) * 16384 + c * 64; NT = 64; }
  else { int su = u - 2048; h = su & 3; T0 = MP + (su >> 2) * 32; NT = 32; }
  const float* LR = (const float*)(ws + W_LR);
  if (tid < 256) {
    int t = tid >> 2;
    f32x4 v = f32x4{0.f, 0.f, 0.f, 0.f};
    if (t < NT) v = *(const f32x4*)(LR + (size_t)(T0 + t) * 16 + (tid & 3) * 4);
    *(f32x4*)(lr_s + tid * 4) = v;
  }
  __syncthreads();
  {
    const int col = tid & 127, tq = tid >> 7;
    float w[16];
#pragma unroll
    for (int r = 0; r < 16; ++r) w[r] = P.w_gu[r * 512 + h * 128 + col];
    const float bias = P.b_gate[h * 128 + col];
    float run = 0.f;
#pragma unroll 4
    for (int tt = 0; tt < 16; ++tt) {
      const int t = tq * 16 + tt;
      float x = bias;
#pragma unroll
      for (int r4 = 0; r4 < 4; ++r4) {
        f32x4 l4 = *(const f32x4*)(lr_s + t * 16 + r4 * 4);
        x += l4[0] * w[r4 * 4] + l4[1] * w[r4 * 4 + 1] + l4[2] * w[r4 * 4 + 2] + l4[3] * w[r4 * 4 + 3];
      }
      float g = (fminf(x, 0.f) - __logf(1.f + __expf(-fabsf(x)))) * (1.f / 16.f);
      if (t >= NT) g = 0.f;
      run += g;
      b_s[t * 128 + col] = run;
    }
    seg_s[tq * 128 + col] = run;
  }
  __syncthreads();
  {
    u16* Q1 = (u16*)(ws + W_Q1);
    u16* K1 = (u16*)(ws + W_K1);
    float* DEC = (float*)(ws + W_DEC);
#pragma unroll
    for (int i = 0; i < 2; ++i) {
      const int e = tid + i * 512, t = e >> 4, c8 = (e & 15) * 8, tq = t >> 4;
      float bb[8], bl[8];
#pragma unroll
      for (int j = 0; j < 8; ++j) {
        float s0 = seg_s[c8 + j], s1 = seg_s[128 + c8 + j], s2 = seg_s[256 + c8 + j], s3 = seg_s[384 + c8 + j];
        float pre = (tq > 0 ? s0 : 0.f) + (tq > 1 ? s1 : 0.f) + (tq > 2 ? s2 : 0.f);
        bb[j] = b_s[t * 128 + c8 + j] + pre;
        bl[j] = s0 + s1 + s2 + s3;
      }
      u32x4 qv = u32x4{0u, 0u, 0u, 0u}, kv = u32x4{0u, 0u, 0u, 0u};
      const size_t off = (size_t)(T0 + t) * 512 + h * 128 + c8;
      if (t < NT) { qv = *(const u32x4*)(Q1 + off); kv = *(const u32x4*)(K1 + off); }
      u32x4 qo, ko;
      float kd[8];
#pragma unroll
      for (int jj = 0; jj < 4; ++jj) {
        float q0 = bflo(qv[jj]), q1 = bfhi(qv[jj]), k0 = bflo(kv[jj]), k1 = bfhi(kv[jj]);
        float e0 = __expf(bb[2 * jj]), e1 = __expf(bb[2 * jj + 1]);
        float i0 = __expf(-bb[2 * jj]), i1 = __expf(-bb[2 * jj + 1]);
        qo[jj] = pk_bf16(q0 * e0, q1 * e1);
        ko[jj] = pk_bf16(k0 * i0, k1 * i1);
        kd[2 * jj] = k0 * __expf(bl[2 * jj] - bb[2 * jj]);
        kd[2 * jj + 1] = k1 * __expf(bl[2 * jj + 1] - bb[2 * jj + 1]);
      }
      if (t < NT) { *(u32x4*)(Q1 + off) = qo; *(u32x4*)(K1 + off) = ko; }
#pragma unroll
      for (int j = 0; j < 8; ++j) kdT[(c8 + j) * 72 + t] = f2bf(kd[j]);
      if (t == 0) {
#pragma unroll
        for (int j = 0; j < 8; ++j) DEC[(size_t)u * 128 + c8 + j] = __expf(bl[j]);
      }
    }
  }
  __syncthreads();
  {
    const int mt = wid & 3, ng = wid >> 2, l31 = lane & 31, hf = lane >> 5;
    bf16x8 a[4];
#pragma unroll
    for (int ks = 0; ks < 4; ++ks) a[ks] = *(const bf16x8*)(kdT + (mt * 32 + l31) * 72 + ks * 16 + hf * 8);
    const u16* VT1 = (const u16*)(ws + W_VT1) + (size_t)u * 16384;
    float* U = (float*)(ws + W_U) + (size_t)u * 32768;
#pragma unroll
    for (int q = 0; q < 4; ++q) {
      const int ntile = ng * 4 + q;
      f32x16 c;
#pragma unroll
      for (int i = 0; i < 16; ++i) c[i] = 0.f;
#pragma unroll
      for (int ks = 0; ks < 4; ++ks) {
        bf16x8 bfr = *(const bf16x8*)(VT1 + (ntile * 32 + l31) * 64 + ks * 16 + hf * 8);
        c = __builtin_amdgcn_mfma_f32_32x32x16_bf16(a[ks], bfr, c, 0, 0, 0);
      }
#pragma unroll
      for (int g = 0; g < 4; ++g) {
        f32x4 o = f32x4{c[4 * g], c[4 * g + 1], c[4 * g + 2], c[4 * g + 3]};
        *(f32x4*)(U + ((size_t)((ntile * 8 + mt * 2 + (g >> 1)) * 64 + (g & 1) * 32 + l31)) * 8 + 4 * hf) = o;
      }
    }
  }
  __syncthreads();
}

DI void swa_unit(const Params& P, const u16* __restrict__ kb, const u16* __restrict__ vb, const int vstride,
                 const int pos0, const int kt_start, const int nkt, const int T0, const int kvh, const int g,
                 const int tofs) {
  char* ws = P.ws;
  const int lane = get_tid() & 63, l31 = lane & 31, hf = lane >> 5;
  const u16* Q2 = (const u16*)(ws + W_Q2);
  const int hc = kvh * 256 + g * 64;
  const size_t qrow = (size_t)(T0 + tofs + l31);
  bf16x8 qf[4];
#pragma unroll
  for (int ks = 0; ks < 4; ++ks) qf[ks] = *(const bf16x8*)(Q2 + qrow * 1024 + hc + ks * 16 + hf * 8);
  f32x16 s[6];
#pragma unroll
  for (int kt = 0; kt < 6; ++kt) {
#pragma unroll
    for (int i = 0; i < 16; ++i) s[kt][i] = -1e30f;
    if (kt >= kt_start && kt < nkt) {
      f32x16 c;
#pragma unroll
      for (int i = 0; i < 16; ++i) c[i] = 0.f;
      const u16* kp = kb + (size_t)(pos0 + kt * 32 + l31) * 64 + hf * 8;
#pragma unroll
      for (int ks = 0; ks < 4; ++ks) {
        bf16x8 kf = *(const bf16x8*)(kp + ks * 16);
        c = __builtin_amdgcn_mfma_f32_32x32x16_bf16(kf, qf[ks], c, 0, 0, 0);
      }
      s[kt] = c;
    }
  }
  const float sink = P.sinks[kvh * 4 + g];
  float mx = sink;
#pragma unroll
  for (int kt = 0; kt < 6; ++kt)
#pragma unroll
    for (int i = 0; i < 16; ++i) mx = fmaxf(mx, s[kt][i]);
  mx = fmaxf(mx, __shfl_xor(mx, 32));
  float sum = 0.f;
#pragma unroll
  for (int kt = 0; kt < 6; ++kt)
#pragma unroll
    for (int i = 0; i < 16; ++i) {
      float p = __expf(s[kt][i] - mx);
      s[kt][i] = p;
      sum += p;
    }
  sum += __shfl_xor(sum, 32);
  sum += __expf(sink - mx);
  const float inv = 1.f / sum;
  f32x16 o[2];
#pragma unroll
  for (int nt2 = 0; nt2 < 2; ++nt2)
#pragma unroll
    for (int i = 0; i < 16; ++i) o[nt2][i] = 0.f;
#pragma unroll
  for (int kt = 0; kt < 6; ++kt) {
    if (kt >= kt_start && kt < nkt) {
#pragma unroll
      for (int sub = 0; sub < 2; ++sub) {
        union { bf16x8 v; unsigned w[4]; } pf;
#pragma unroll
        for (int jj = 0; jj < 4; ++jj)
          pf.w[jj] = pk_bf16(s[kt][sub * 8 + 2 * jj] * inv, s[kt][sub * 8 + 2 * jj + 1] * inv);
        const int key0 = pos0 + kt * 32 + sub * 16 + 4 * hf;
#pragma unroll
        for (int nt2 = 0; nt2 < 2; ++nt2) {
          const u16* vp = vb + (size_t)(nt2 * 32 + l31) * vstride + key0;
          union { bf16x8 v; u32x2 h2[2]; } vf;
          vf.h2[0] = *(const u32x2*)(vp);
          vf.h2[1] = *(const u32x2*)(vp + 8);
          o[nt2] = __builtin_amdgcn_mfma_f32_32x32x16_bf16(pf.v, vf.v, o[nt2], 0, 0, 0);
        }
      }
    }
  }
  const u16* Z2 = (const u16*)(ws + W_Z2);
  u16* MIX = (u16*)(ws + W_MIX);
#pragma unroll
  for (int nt2 = 0; nt2 < 2; ++nt2)
#pragma unroll
    for (int i = 0; i < 16; ++i) {
      const int t = (i & 3) + 8 * (i >> 2) + 4 * hf;
      const size_t row = (size_t)(T0 + tofs + t);
      const int col = hc + nt2 * 32 + l31;
      float z = bf2f(Z2[row * 1024 + col]);
      MIX[row * 2048 + 1024 + col] = f2bf(o[nt2][i] * siluf_(z));
    }
}

DI void phase_mix1() {
  const Params P = load_params();
  char* ws = P.ws;
  const int wid = get_tid() >> 6;
  const int total = NU + 2048 + 32;
  for (int item = blockIdx.x; item < total; item += gridDim.x) {
    if (item < NU) {
      gla_p1_unit(P, item);
    } else if (item < NU + 2048) {
      const int q = item - NU, kvh = q & 3, c = (q >> 2) & 255, b = q >> 10;
      const u16* kb = (const u16*)(ws + W_K2P) + (size_t)(b * 4 + kvh) * 16384 * 64;
      const u16* vb = (const u16*)(ws + W_VT2P) + (size_t)(b * 4 + kvh) * 64 * 16384;
      const int kt_start = c == 0 ? 4 : (c == 1 ? 2 : 0);
      swa_unit(P, kb, vb, 16384, c * 64 - 128, kt_start, 6, b * 16384 + c * 64, kvh, wid >> 1, (wid & 1) * 32);
    } else {
      const int q = item - NU - 2048, kvh = q & 3, sb = q >> 2;
      if (wid < 4) {
        const u16* kb = (const u16*)(ws + W_K2S) + (size_t)(sb * 4 + kvh) * 160 * 64;
        const u16* vb = (const u16*)(ws + W_VT2S) + (size_t)(sb * 4 + kvh) * 64 * 160;
        swa_unit(P, kb, vb, 160, 0, 0, 5, MP + sb * 32, kvh, wid, 0);
      }
    }
  }
}

DI void phase_scan() {
  const Params P = load_params();
  char* ws = P.ws;
  const float* U = (const float*)(ws + W_U);
  u16* S = (u16*)(ws + W_S);
  const float* DEC = (const float*)(ws + W_DEC);
  const int gtid = blockIdx.x * 512 + get_tid(), gsz = gridDim.x * 512;
  for (int item = gtid; item < 8 * 16384; item += gsz) {
    const int sh = item >> 14, q2 = item & 16383;
    const int j0 = (q2 & 3) * 2, ln = (q2 >> 2) & 63, ks = (q2 >> 8) & 7, ntl = q2 >> 11;
    const int dk = ks * 16 + (ln >> 5) * 8 + j0, dv = ntl * 32 + (ln & 31);
    float s0 = 0.f, s1 = 0.f;
    const size_t ubase = (size_t)sh * 256 * 32768 + (size_t)q2 * 2;
    const size_t dbase = (size_t)sh * 256 * 128 + dk;
    for (int c0 = 0; c0 < 256; c0 += 8) {
      float2 uu[8], dd[8];
#pragma unroll
      for (int i = 0; i < 8; ++i) {
        uu[i] = *(const float2*)(U + ubase + (size_t)(c0 + i) * 32768);
        dd[i] = *(const float2*)(DEC + dbase + (size_t)(c0 + i) * 128);
      }
#pragma unroll
      for (int i = 0; i < 8; ++i) {
        *(unsigned*)(S + ubase + (size_t)(c0 + i) * 32768) = pk_bf16(s0, s1);
        s0 = dd[i].x * s0 + uu[i].x;
        s1 = dd[i].y * s1 + uu[i].y;
      }
    }
    float* o = P.out + O_SGP + (size_t)sh * 32768 + (size_t)dk * 256 + dv;
    o[0] = s0;
    o[256] = s1;
  }
  for (int item = gtid; item < 32 * 16384; item += gsz) {
    const int su = item >> 14, q2 = item & 16383;
    const int j0 = (q2 & 3) * 2, ln = (q2 >> 2) & 63, ks = (q2 >> 8) & 7, ntl = q2 >> 11;
    const int dk = ks * 16 + (ln >> 5) * 8 + j0, dv = ntl * 32 + (ln & 31);
    const float2 uu = *(const float2*)(U + (size_t)(2048 + su) * 32768 + (size_t)q2 * 2);
    const float2 dd = *(const float2*)(DEC + (size_t)(2048 + su) * 128 + dk);
    const float* s0p = P.state + (size_t)su * 32768 + (size_t)dk * 256 + dv;
    float* o = P.out + O_SGS + (size_t)su * 32768 + (size_t)dk * 256 + dv;
    o[0] = dd.x * s0p[0] + uu.x;
    o[256] = dd.y * s0p[256] + uu.y;
  }
}

DI void gla_p3_wave(const Params& P, const int u, const int ti, const int lane, const int wid) {
  char* ws = P.ws;
  const int l31 = lane & 31, hf = lane >> 5;
  int T0, NT, h;
  if (u < 2048) { int sh = u >> 8, c = u & 255; h = sh & 3; T0 = (sh >> 2) * 16384 + c * 64; NT = 64; }
  else { int su = u - 2048; h = su & 3; T0 = MP + (su >> 2) * 32; NT = 32; }
  if (ti * 32 >= NT) return;
  const u16* Q1 = (const u16*)(ws + W_Q1);
  const u16* K1 = (const u16*)(ws + W_K1);
  const u16* VT1 = (const u16*)(ws + W_VT1) + (size_t)u * 16384;
  const u16* S = (const u16*)(ws + W_S) + (size_t)u * 32768;
  const size_t trow = (size_t)(T0 + ti * 32 + l31);
  bf16x8 qf[8];
#pragma unroll
  for (int ks = 0; ks < 8; ++ks) qf[ks] = *(const bf16x8*)(Q1 + trow * 512 + h * 128 + ks * 16 + hf * 8);
  f32x16 at0, at1;
#pragma unroll
  for (int i = 0; i < 16; ++i) { at0[i] = 0.f; at1[i] = 0.f; }
  {
    const u16* kp = K1 + (size_t)(T0 + l31) * 512 + h * 128 + hf * 8;
#pragma unroll
    for (int ks = 0; ks < 8; ++ks) {
      bf16x8 kf = *(const bf16x8*)(kp + ks * 16);
      at0 = __builtin_amdgcn_mfma_f32_32x32x16_bf16(kf, qf[ks], at0, 0, 0, 0);
    }
    if (ti == 1) {
#pragma unroll
      for (int ks = 0; ks < 8; ++ks) {
        bf16x8 kf = *(const bf16x8*)(kp + 32 * 512 + ks * 16);
        at1 = __builtin_amdgcn_mfma_f32_32x32x16_bf16(kf, qf[ks], at1, 0, 0, 0);
      }
    }
  }
  union PF { bf16x8 v; unsigned wd[4]; };
  PF p0[2], p1[2];
#pragma unroll
  for (int sub = 0; sub < 2; ++sub)
#pragma unroll
    for (int jj = 0; jj < 4; ++jj) {
      const int i0 = sub * 8 + 2 * jj, i1 = i0 + 1;
      const int s0 = (i0 & 3) + 8 * (i0 >> 2) + 4 * hf, s1 = (i1 & 3) + 8 * (i1 >> 2) + 4 * hf;
      const bool d0 = (ti == 0);
      p0[sub].wd[jj] = pk_bf16((!d0 || s0 <= l31) ? at0[i0] : 0.f, (!d0 || s1 <= l31) ? at0[i1] : 0.f);
      p1[sub].wd[jj] = pk_bf16(s0 <= l31 ? at1[i0] : 0.f, s1 <= l31 ? at1[i1] : 0.f);
    }
  f32x16 acc[8];
#pragma unroll
  for (int nt = 0; nt < 8; ++nt) {
#pragma unroll
    for (int i = 0; i < 16; ++i) acc[nt][i] = 0.f;
    const u16* vp = VT1 + (size_t)(nt * 32 + l31) * 64 + 4 * hf;
#pragma unroll
    for (int sub = 0; sub < 2; ++sub) {
      union { bf16x8 v; u32x2 h2[2]; } vf;
      vf.h2[0] = *(const u32x2*)(vp + sub * 16);
      vf.h2[1] = *(const u32x2*)(vp + sub * 16 + 8);
      acc[nt] = __builtin_amdgcn_mfma_f32_32x32x16_bf16(vf.v, p0[sub].v, acc[nt], 0, 0, 0);
    }
    if (ti == 1) {
#pragma unroll
      for (int sub = 0; sub < 2; ++sub) {
        union { bf16x8 v; u32x2 h2[2]; } vf;
        vf.h2[0] = *(const u32x2*)(vp + 32 + sub * 16);
        vf.h2[1] = *(const u32x2*)(vp + 32 + sub * 16 + 8);
        acc[nt] = __builtin_amdgcn_mfma_f32_32x32x16_bf16(vf.v, p1[sub].v, acc[nt], 0, 0, 0);
      }
    }
#pragma unroll
    for (int ks = 0; ks < 8; ++ks) {
      bf16x8 sf = *(const bf16x8*)(S + ((size_t)(nt * 8 + ks) * 64 + lane) * 8);
      acc[nt] = __builtin_amdgcn_mfma_f32_32x32x16_bf16(sf, qf[ks], acc[nt], 0, 0, 0);
    }
  }
  float ss = 0.f;
#pragma unroll
  for (int nt = 0; nt < 8; ++nt)
#pragma unroll
    for (int i = 0; i < 16; ++i) ss += acc[nt][i] * acc[nt][i];
  ss += __shfl_xor(ss, 32);
  const float rstd = rsqrtf(ss * (1.f / 256.f) + EPS);
  unsigned char* wl = smem_raw + wid * 16384;
  const float* gg = P.g_gla + 4 * hf;
  const int rr = lane >> 4, c16 = lane & 15;
#pragma unroll
  for (int half = 0; half < 2; ++half) {
#pragma unroll
    for (int n2 = 0; n2 < 4; ++n2)
#pragma unroll
      for (int g4 = 0; g4 < 4; ++g4) {
        const int nt = half * 4 + n2;
        const int dvl = n2 * 32 + 8 * g4 + 4 * hf;
        const f32x4 gv = *(const f32x4*)(gg + half * 128 + n2 * 32 + 8 * g4);
        u32x2 oo;
        oo[0] = pk_bf16(acc[nt][4 * g4] * rstd * gv[0], acc[nt][4 * g4 + 1] * rstd * gv[1]);
        oo[1] = pk_bf16(acc[nt][4 * g4 + 2] * rstd * gv[2], acc[nt][4 * g4 + 3] * rstd * gv[3]);
        *(u32x2*)(wl + l31 * 272 + dvl * 2) = oo;
      }
    u32x4 zz[8];
#pragma unroll
    for (int i = 0; i < 8; ++i) {
      const size_t row = (size_t)(T0 + ti * 32 + i * 4 + rr);
      zz[i] = *(const u32x4*)((const u16*)(ws + W_Z1) + row * 1024 + h * 256 + half * 128 + c16 * 8);
    }
#pragma unroll
    for (int i = 0; i < 8; ++i) {
      const size_t row = (size_t)(T0 + ti * 32 + i * 4 + rr);
      const u32x4 ov = *(const u32x4*)(wl + (i * 4 + rr) * 272 + c16 * 16);
      u32x4 r;
#pragma unroll
      for (int q = 0; q < 4; ++q)
        r[q] = pk_bf16(bflo(ov[q]) * siluf_(bflo(zz[i][q])), bfhi(ov[q]) * siluf_(bfhi(zz[i][q])));
      *(u32x4*)((u16*)(ws + W_MIX) + row * 2048 + h * 256 + half * 128 + c16 * 8) = r;
    }
  }
}

DI void phase_p3() {
  const Params P = load_params();
  const int tid = get_tid(), lane = tid & 63;
  const int wid = __builtin_amdgcn_readfirstlane(tid >> 6);
  for (int task = blockIdx.x * 8 + wid; task < NU * 2; task += gridDim.x * 8) gla_p3_wave(P, task >> 1, task & 1, lane, wid);
}

DI void phase_outproj() {
  const Params P = load_params();
  char* ws = P.ws;
  const u16* MIX = (const u16*)(ws + W_MIX);
  const u16* WOUT = (const u16*)(ws + W_WOUT);
  u16* HB = (u16*)(ws + W_HB);
  float* RSQH = (float*)(ws + W_RSQH);
  int* CNT = (int*)(ws + W_CNT);
  const int tid = get_tid();
  const int wid = __builtin_amdgcn_readfirstlane(tid >> 6), wr = wid >> 2, wc = wid & 3;
  f32x4 acc[2][2][4][2];
  int pm, pn;
  for (int it = 0; next_tile(it, 129, 8, pm, pn); ++it) {
    const int brow = pm * 256, bcol = pn * 256;
    gemm_kloop(MIX, WOUT, 2048, brow, bcol, acc, tid);
    int te = tid;
    asm volatile("" : "+v"(te));
    const int fr = te & 15, fq = (te >> 4) & 3;
    {
      f32x4 xv[8][4];
      const int cb = bcol + wc * 32 + fq * 4;
#define P5_ISSUE(g)                                                                                          \
  {                                                                                                          \
    const int row_ = brow + ((g) >> 2) * 128 + wr * 64 + ((g)&3) * 16 + fr;                                   \
    const float* xr_ = (row_ < MP ? P.x_p + (size_t)row_ * 2048 : P.x_s + (size_t)(row_ - MP) * 2048) + cb;  \
    xv[g][0] = *(const f32x4*)(xr_);                                                                         \
    xv[g][1] = *(const f32x4*)(xr_ + 16);                                                                    \
    xv[g][2] = *(const f32x4*)(xr_ + 128);                                                                   \
    xv[g][3] = *(const f32x4*)(xr_ + 144);                                                                   \
  }
      P5_ISSUE(0) P5_ISSUE(1) P5_ISSUE(2)
#pragma unroll
      for (int g = 0; g < 8; ++g) {
        if (g + 3 < 8) {
          switch (g + 3) {
            case 3: P5_ISSUE(3) break;
            case 4: P5_ISSUE(4) break;
            case 5: P5_ISSUE(5) break;
            case 6: P5_ISSUE(6) break;
            case 7: P5_ISSUE(7) break;
          }
        }
        __builtin_amdgcn_sched_barrier(0);
        const int ai = g >> 2, m = g & 3;
        const int row = brow + ai * 128 + wr * 64 + m * 16 + fr;
        float ss = 0.f;
#pragma unroll
        for (int bj = 0; bj < 2; ++bj)
#pragma unroll
          for (int n = 0; n < 2; ++n) {
            const int col = cb + bj * 128 + n * 16;
            f32x4 hv = acc[ai][bj][m][n] + xv[g][bj * 2 + n];
            ss += hv[0] * hv[0] + hv[1] * hv[1] + hv[2] * hv[2] + hv[3] * hv[3];
            const unsigned long long pk = (unsigned long long)pk_bf16(hv[0], hv[1]) | ((unsigned long long)pk_bf16(hv[2], hv[3]) << 32);
            __hip_atomic_store((unsigned long long*)(HB + (size_t)row * 2048 + col), pk, __ATOMIC_RELAXED, __HIP_MEMORY_SCOPE_AGENT);
          }
        ss += __shfl_xor(ss, 16);
        ss += __shfl_xor(ss, 32);
        if (fq == 0) __hip_atomic_store(RSQH + (size_t)row * 32 + pn * 4 + wc, ss, __ATOMIC_RELAXED, __HIP_MEMORY_SCOPE_AGENT);
        __builtin_amdgcn_sched_barrier(0);
      }
#undef P5_ISSUE
    }
    asm volatile("s_waitcnt vmcnt(0)" ::: "memory");
    __syncthreads();
    if (tid == 0) __hip_atomic_fetch_add(CNT + pm, 1, __ATOMIC_RELAXED, __HIP_MEMORY_SCOPE_AGENT);
  }
}

DI void phase_ple() {
  const Params P = load_params();
  char* ws = P.ws;
  const u16* HB = (const u16*)(ws + W_HB);
  const u16* WG = (const u16*)(ws + W_WG);
  const u16* PB = (const u16*)(ws + W_PB);
  const u16* WP = (const u16*)(ws + W_WP);
  const float* RSQH = (const float*)(ws + W_RSQH);
  float* RSQH2 = (float*)(ws + W_RSQH2);
  u16* H2B = (u16*)(ws + W_H2B);
  u32x4* stash = (u32x4*)(ws + W_STASH + (size_t)blockIdx.x * 131072);
  const int tid = get_tid();
  const int wid = __builtin_amdgcn_readfirstlane(tid >> 6), wr = wid >> 2, wc = wid & 3;
  f32x4 acc[2][2][4][2];
  int pm, pn;
  int* CNT = (int*)(ws + W_CNT);
  const int rot = (gridDim.x >= 128) ? 64 : 0;
  for (int it = 0; next_tile(it, 129, 8, pm, pn, rot); ++it) {
    const int brow = pm * 256, bcol = pn * 256;
    if (tid == 0) {
      while (__hip_atomic_load(CNT + pm, __ATOMIC_RELAXED, __HIP_MEMORY_SCOPE_AGENT) < 8) __builtin_amdgcn_s_sleep(4);
      __builtin_amdgcn_fence(__ATOMIC_ACQUIRE, "agent");
    }
    __syncthreads();
    gemm_kloop(HB, WG, 2048, brow, bcol, acc, tid);
    int te = tid;
    asm volatile("" : "+v"(te));
    const int fr = te & 15, fq = (te >> 4) & 3;
    float rq[8];
    {
      f32x4 pa[8][2];
#pragma unroll
      for (int g = 0; g < 8; ++g) {
        const float* pp_ = RSQH + (size_t)(brow + (g >> 2) * 128 + wr * 64 + (g & 3) * 16 + fr) * 32 + fq * 8;
        pa[g][0] = *(const f32x4*)pp_;
        pa[g][1] = *(const f32x4*)(pp_ + 4);
      }
#pragma unroll
      for (int g = 0; g < 8; ++g) {
        f32x4 t4 = pa[g][0] + pa[g][1];
        float s_ = (t4[0] + t4[1]) + (t4[2] + t4[3]);
        s_ += __shfl_xor(s_, 16);
        s_ += __shfl_xor(s_, 32);
        rq[g] = s_;
      }
    }
#pragma unroll
    for (int ai = 0; ai < 2; ++ai)
#pragma unroll
      for (int m = 0; m < 4; ++m) {
        const float rs = rsqrtf(rq[ai * 4 + m] * (1.f / 2048.f) + EPS);
#pragma unroll
        for (int bj = 0; bj < 2; ++bj) {
          f32x4 a = acc[ai][bj][m][0], bq = acc[ai][bj][m][1];
          u32x4 o;
          o[0] = pk_bf16(sigmoidf_(a[0] * rs), sigmoidf_(a[1] * rs));
          o[1] = pk_bf16(sigmoidf_(a[2] * rs), sigmoidf_(a[3] * rs));
          o[2] = pk_bf16(sigmoidf_(bq[0] * rs), sigmoidf_(bq[1] * rs));
          o[3] = pk_bf16(sigmoidf_(bq[2] * rs), sigmoidf_(bq[3] * rs));
          stash[(size_t)((ai * 4 + m) * 2 + bj) * 512 + te] = o;
        }
        __builtin_amdgcn_sched_barrier(0);
      }
    gemm_kloop(PB, WP, 256, brow, bcol, acc, tid);
    int te2 = tid;
    asm volatile("" : "+v"(te2));
    const int fr2 = te2 & 15, fq2 = (te2 >> 4) & 3;
    {
      u32x4 gs[8][2];
      u32x2 hr[8][4];
      const int cb = bcol + wc * 32 + fq2 * 4;
#define P6_ISSUE(g)                                                                          \
  {                                                                                          \
    const int row_ = brow + ((g) >> 2) * 128 + wr * 64 + ((g)&3) * 16 + fr2;                  \
    const u16* hp_ = HB + (size_t)row_ * 2048 + cb;                                          \
    gs[g][0] = stash[(size_t)((g)*2 + 0) * 512 + te2];                                       \
    gs[g][1] = stash[(size_t)((g)*2 + 1) * 512 + te2];                                       \
    hr[g][0] = *(const u32x2*)(hp_);                                                         \
    hr[g][1] = *(const u32x2*)(hp_ + 16);                                                    \
    hr[g][2] = *(const u32x2*)(hp_ + 128);                                                   \
    hr[g][3] = *(const u32x2*)(hp_ + 144);                                                   \
  }
      P6_ISSUE(0) P6_ISSUE(1) P6_ISSUE(2)
#pragma unroll
      for (int g = 0; g < 8; ++g) {
        if (g + 3 < 8) {
          switch (g + 3) {
            case 3: P6_ISSUE(3) break;
            case 4: P6_ISSUE(4) break;
            case 5: P6_ISSUE(5) break;
            case 6: P6_ISSUE(6) break;
            case 7: P6_ISSUE(7) break;
          }
        }
        __builtin_amdgcn_sched_barrier(0);
        const int ai = g >> 2, m = g & 3;
        const int row = brow + ai * 128 + wr * 64 + m * 16 + fr2;
        float ss = 0.f;
#pragma unroll
        for (int bj = 0; bj < 2; ++bj) {
          const u32x4 gt = gs[g][bj];
#pragma unroll
          for (int n = 0; n < 2; ++n) {
            const int col = cb + bj * 128 + n * 16;
            const u32x2 hraw = hr[g][bj * 2 + n];
            f32x4 hv = f32x4{bflo(hraw[0]), bfhi(hraw[0]), bflo(hraw[1]), bfhi(hraw[1])};
            f32x4 pp = acc[ai][bj][m][n];
            f32x4 gv = f32x4{bflo(gt[2 * n]), bfhi(gt[2 * n]), bflo(gt[2 * n + 1]), bfhi(gt[2 * n + 1])};
            f32x4 h2 = hv + gv * pp;
            ss += h2[0] * h2[0] + h2[1] * h2[1] + h2[2] * h2[2] + h2[3] * h2[3];
            store_bf4(H2B + (size_t)row * 2048 + col, h2);
          }
        }
        ss += __shfl_xor(ss, 16);
        ss += __shfl_xor(ss, 32);
        if (fq2 == 0) RSQH2[(size_t)row * 32 + pn * 4 + wc] = ss;
        __builtin_amdgcn_sched_barrier(0);
      }
#undef P6_ISSUE
    }
  }
}

DI void phase_final() {
  const Params P = load_params();
  const float* RSQH2 = (const float*)(P.ws + W_RSQH2);
  const u16* H2B = (const u16*)(P.ws + W_H2B);
  const int tid = get_tid(), lane = tid & 63, wid = tid >> 6;
  f32x4 gf[4][2];
#pragma unroll
  for (int i = 0; i < 4; ++i) {
    gf[i][0] = *(const f32x4*)(P.g_final + i * 512 + lane * 8);
    gf[i][1] = *(const f32x4*)(P.g_final + i * 512 + lane * 8 + 4);
  }
  for (int r0 = (blockIdx.x * 8 + wid) * 2; r0 < MT; r0 += gridDim.x * 16) {
    u32x4 hv[2][4];
    float pr[2];
#pragma unroll
    for (int j = 0; j < 2; ++j) {
      pr[j] = RSQH2[(size_t)(r0 + j) * 32 + (lane & 31)];
#pragma unroll
      for (int i = 0; i < 4; ++i) hv[j][i] = __builtin_nontemporal_load((const u32x4*)(H2B + (size_t)(r0 + j) * 2048 + i * 512 + lane * 8));
    }
#pragma unroll
    for (int j = 0; j < 2; ++j) {
      float s_ = pr[j];
#pragma unroll
      for (int o = 16; o >= 1; o >>= 1) s_ += __shfl_xor(s_, o);
      const float rs = rsqrtf(s_ * (1.f / 2048.f) + EPS);
      float* op = P.out + O_Y + (size_t)(r0 + j) * 2048 + lane * 8;
#pragma unroll
      for (int i = 0; i < 4; ++i) {
        const u32x4 h = hv[j][i];
        f32x4 o0 = f32x4{bflo(h[0]), bfhi(h[0]), bflo(h[1]), bfhi(h[1])} * rs * gf[i][0];
        f32x4 o1 = f32x4{bflo(h[2]), bfhi(h[2]), bflo(h[3]), bfhi(h[3])} * rs * gf[i][1];
        __builtin_nontemporal_store(o0, (f32x4*)(op + i * 512));
        __builtin_nontemporal_store(o1, (f32x4*)(op + i * 512 + 4));
      }
    }
  }
}

__global__ void __launch_bounds__(512, 2) hymba_megakernel(Params Pk) {
  cg::grid_group grid = cg::this_grid();
  const int ph_lo = Pk.ph_lo, ph_hi = Pk.ph_hi;
#ifndef PROBE_MASK
#define PROBE_MASK 0
#endif
#define PROBE_MULT 2
#define RUN_PHASE(ph, call)                                   \
  if (ph_lo <= ph && ph < ph_hi) {                            \
    if (ph > ph_lo) grid.sync();                              \
    long long t0_ = 0;                                        \
    if (PROBE_MASK) t0_ = wall_clock64();                     \
    call;                                                     \
    if ((PROBE_MASK >> ph) & 1) {                             \
      if (ph == 7) __syncthreads();                           \
      probe_acc += wall_clock64() - t0_;                      \
    }                                                         \
  }
  long long probe_acc = 0;
  RUN_PHASE(0, phase_prep())
  RUN_PHASE(1, phase_inproj())
  RUN_PHASE(2, phase_mix1())
  RUN_PHASE(3, phase_scan())
  RUN_PHASE(4, phase_p3())
  RUN_PHASE(5, (phase_outproj(), phase_ple()))
  RUN_PHASE(7, phase_final())
  if (PROBE_MASK) {
    const long long tend = wall_clock64() + PROBE_MULT * probe_acc;
    while (wall_clock64() < tend) __builtin_amdgcn_s_sleep(8);
  }
}

extern "C" void kernel_launch(void* const* d_in, const int* in_sizes, int n_in, void* d_out, int out_size, void* d_ws,
                              size_t ws_size, hipStream_t stream) {
  static int grid_blocks = 0;
  if (!grid_blocks) {
    hipFuncSetAttribute((const void*)hymba_megakernel, hipFuncAttributeMaxDynamicSharedMemorySize, SHM_B);
    int dev = 0, cus = 0, per_cu = 0;
    hipGetDevice(&dev);
    hipDeviceGetAttribute(&cus, hipDeviceAttributeMultiprocessorCount, dev);
    hipOccupancyMaxActiveBlocksPerMultiprocessor(&per_cu, hymba_megakernel, 512, SHM_B);
    if (per_cu < 1) per_cu = 1;
    if (per_cu > 1) per_cu = 1;
    grid_blocks = cus * per_cu;
  }
  Params p{};
  p.x_p = (const float*)d_in[0]; p.x_s = (const float*)d_in[1]; p.p_p = (const float*)d_in[2];
  p.p_s = (const float*)d_in[3]; p.state = (const float*)d_in[4]; p.ck = (const float*)d_in[5];
  p.cv = (const float*)d_in[6]; p.g_mix = (const float*)d_in[7]; p.w_in = (const float*)d_in[8];
  p.w_gu = (const float*)d_in[9]; p.b_gate = (const float*)d_in[10]; p.g_gla = (const float*)d_in[11];
  p.sinks = (const float*)d_in[12]; p.w_out = (const float*)d_in[13]; p.g_ple = (const float*)d_in[14];
  p.w_pg = (const float*)d_in[15]; p.w_pp = (const float*)d_in[16]; p.g_final = (const float*)d_in[17];
  p.out = (float*)d_out;
  p.ws = (char*)d_ws;
  p.ph_lo = 0;
  p.ph_hi = 8;
  void* args[] = {&p};
  hipError_t e = hipLaunchCooperativeKernel((const void*)hymba_megakernel, dim3(grid_blocks), dim3(512), args, SHM_B, stream);
  if (e != hipSuccess) fprintf(stderr, "cooperative launch failed: %s (grid %d)\n", hipGetErrorString(e), grid_blocks);
}
```
